# Optimizing an MI355X kernel written in HIP

```python
import math
import jax, jax.numpy as jnp
from jax import lax
import numpy as np

D_MODEL = 2048
BATCH = 2
SEQ = 4096
DEPTH = 1
DEC_BATCH = 8
DEC_SEQ = 32
PAST_LEN = 4096

CHUNK = 64
E_SSD = D_MODEL
SSD_HEAD_DIM = 64
SSD_HEADS = E_SSD // SSD_HEAD_DIM
SSD_GROUPS = 4
D_STATE = 128
CONV_W = 4
CONV_DIM = E_SSD + 2 * SSD_GROUPS * D_STATE
E_MLP = D_MODEL
MLP_CHUNK = 128
MLP_GROUPS = 8
MLP_GROUP_DIM = E_MLP // MLP_GROUPS
IN_SIZES = (E_SSD, CONV_DIM, SSD_HEADS, E_MLP, E_MLP, E_MLP, D_MODEL, D_MODEL)
D_IN = E_SSD + CONV_DIM + SSD_HEADS + 3 * E_MLP + 2 * D_MODEL
EPS = 1e-5

kernel_name = "hybrid_ssd_chunkmlp_stream_step"


def _split(a, sizes):
    idx, s = [], 0
    for n in sizes[:-1]:
        s += n
        idx.append(s)
    return jnp.split(a, idx, axis=-1)


def _rmsnorm(x, g):
    xf = x.astype(jnp.float32)
    y = xf * lax.rsqrt(jnp.mean(xf * xf, axis=-1, keepdims=True) + EPS)
    return (y * g.astype(jnp.float32)).astype(x.dtype)


def _layernorm(x, g, b):
    xf = x.astype(jnp.float32)
    mu = jnp.mean(xf, axis=-1, keepdims=True)
    var = jnp.mean(jnp.square(xf - mu), axis=-1, keepdims=True)
    y = (xf - mu) * lax.rsqrt(var + EPS)
    return (y * g.astype(jnp.float32) + b.astype(jnp.float32)).astype(x.dtype)


def _causal_dwconv(xbc, hist, w, b):
    L = xbc.shape[1]
    full = jnp.concatenate([hist.astype(xbc.dtype), xbc], axis=1)
    out = b
    for k in range(CONV_W):
        out = out + full[:, k:k + L] * w[k]
    return jax.nn.silu(out), full[:, L:]


def _ssd_scan(x, dt, a, bm, cm, h0, q):
    f32 = jnp.float32
    bsz, L = x.shape[:2]
    nc = L // q
    G, R = SSD_GROUPS, SSD_HEADS // SSD_GROUPS
    P, N = SSD_HEAD_DIM, D_STATE
    xc = x.astype(f32).reshape(bsz, nc, q, G, R, P)
    dtc = dt.astype(f32).reshape(bsz, nc, q, G, R)
    bc = bm.astype(f32).reshape(bsz, nc, q, G, N)
    cc = cm.astype(f32).reshape(bsz, nc, q, G, N)
    acum = jnp.cumsum(dtc * a.astype(f32).reshape(G, R), axis=2)
    xdt = xc * dtc[..., None]
    seg = acum[:, :, :, None] - acum[:, :, None, :]
    mask = jnp.tril(jnp.ones((q, q), bool))[:, :, None, None]
    lmat = jnp.exp(jnp.where(mask, seg, -jnp.inf))
    cb = jnp.einsum('bcign,bcjgn->bcijg', cc, bc)
    y_diag = jnp.einsum('bcijg,bcijgr,bcjgrp->bcigrp', cb, lmat, xdt)
    decay_to_end = jnp.exp(acum[:, :, -1:] - acum)
    states = jnp.einsum('bcjgn,bcjgr,bcjgrp->bcgrpn', bc, decay_to_end, xdt)
    block_decay = jnp.exp(acum[:, :, -1])

    def step(h, inp):
        s, d = inp
        return d[..., None, None] * h + s, h

    h_init = h0.astype(f32).reshape(bsz, G, R, P, N)
    h_last, h_prev = lax.scan(step, h_init, (jnp.swapaxes(states, 0, 1), jnp.swapaxes(block_decay, 0, 1)))
    h_prev = jnp.swapaxes(h_prev, 0, 1)
    y_off = jnp.einsum('bcign,bcgrpn,bcigr->bcigrp', cc, h_prev, jnp.exp(acum))
    y = (y_diag + y_off).reshape(bsz, L, SSD_HEADS, P)
    return y, h_last.reshape(bsz, SSD_HEADS, P, N).astype(h0.dtype)


def _layer(x, c, conv_hist, h0, w_ada, b_ada, g_pre, w_in, conv_w, conv_b, dt_bias, a_log,
           d_skip, norm_ssd, ln_g, ln_b, w_spatial, b_spatial, w_bp_ssd, w_bp_mlp, w_o):
    f32 = jnp.float32
    bsz, L, _ = x.shape
    mods = jax.nn.silu(c) @ w_ada + b_ada
    shift, scale, gate = jnp.split(mods, 3, axis=-1)
    h = _rmsnorm(x, g_pre) * (1 + scale[:, None]) + shift[:, None]
    proj = h @ w_in
    z_s, xbc, dt_raw, u, v, z_m, g_s, g_m = _split(proj, IN_SIZES)
    xbc, new_hist = _causal_dwconv(xbc, conv_hist, conv_w, conv_b)
    xs, bm, cm = _split(xbc, (E_SSD, SSD_GROUPS * D_STATE, SSD_GROUPS * D_STATE))
    dt = jax.nn.softplus(dt_raw.astype(f32) + dt_bias.astype(f32))
    a = -jnp.exp(a_log.astype(f32))
    xs_h = xs.reshape(bsz, L, SSD_HEADS, SSD_HEAD_DIM).astype(f32)
    y, h_new = _ssd_scan(xs_h, dt, a,
                         bm.reshape(bsz, L, SSD_GROUPS, D_STATE),
                         cm.reshape(bsz, L, SSD_GROUPS, D_STATE),
                         h0, min(L, CHUNK))
    y = y + d_skip.astype(f32)[:, None] * xs_h
    y_ssd = _rmsnorm(y.reshape(bsz, L, E_SSD) * jax.nn.silu(z_s.astype(f32)), norm_ssd)
    vn = _layernorm(v, ln_g, ln_b)
    qm = min(L, MLP_CHUNK)
    wm = jnp.where(jnp.tril(jnp.ones((qm, qm), bool)), w_spatial[:, :qm, :qm], 0)
    vr = vn.reshape(bsz, L // qm, qm, MLP_GROUPS, MLP_GROUP_DIM)
    mixed = jnp.einsum('gij,bnjgc->bnigc', wm, vr) + b_spatial[:, :qm].T[:, :, None]
    y_mlp = u * mixed.reshape(bsz, L, E_MLP) * jax.nn.silu(z_m)
    merged = (jax.nn.sigmoid(g_s) * (y_ssd @ w_bp_ssd)
              + jax.nn.sigmoid(g_m) * (y_mlp @ w_bp_mlp))
    out = x + gate[:, None] * (merged @ w_o)
    return out.astype(x.dtype), new_hist, h_new, vn


def setup_inputs(seed: int = 0) -> dict:
    key = jax.random.key(seed)
    ks = jax.random.split(key, 32)
    nrm = jax.random.normal
    dt0 = jnp.exp(jax.random.uniform(ks[14], (DEPTH, SSD_HEADS), minval=math.log(1e-3), maxval=math.log(0.1)))
    return {
        "x_prompt": nrm(ks[0], (BATCH, SEQ, D_MODEL), jnp.float32),
        "x_sample": nrm(ks[1], (DEC_BATCH, DEC_SEQ, D_MODEL), jnp.float32),
        "state_ssm": 0.1 * nrm(ks[2], (DEPTH, DEC_BATCH, SSD_HEADS, SSD_HEAD_DIM, D_STATE), jnp.float32),
        "cache_conv": nrm(ks[3], (DEPTH, DEC_BATCH, CONV_W - 1, CONV_DIM), jnp.float32),
        "c_prompt": nrm(ks[4], (BATCH, D_MODEL), jnp.float32),
        "c_sample": nrm(ks[5], (DEC_BATCH, D_MODEL), jnp.float32),
        "w_ada": 0.5 * D_MODEL ** -0.5 * nrm(ks[6], (DEPTH, D_MODEL, 3 * D_MODEL), jnp.float32),
        "b_ada": 0.02 * nrm(ks[7], (DEPTH, 3 * D_MODEL), jnp.float32),
        "g_pre": 1.0 + 0.02 * nrm(ks[8], (DEPTH, D_MODEL), jnp.float32),
        "w_in": D_MODEL ** -0.5 * nrm(ks[9], (DEPTH, D_MODEL, D_IN), jnp.float32),
        "conv_w": CONV_W ** -0.5 * nrm(ks[10], (DEPTH, CONV_W, CONV_DIM), jnp.float32),
        "conv_b": 0.02 * nrm(ks[11], (DEPTH, CONV_DIM), jnp.float32),
        "dt_bias": dt0 + jnp.log(-jnp.expm1(-dt0)),
        "a_log": jnp.log(jax.random.uniform(ks[12], (DEPTH, SSD_HEADS), minval=1.0, maxval=16.0)),
        "d_skip": 1.0 + 0.02 * nrm(ks[13], (DEPTH, SSD_HEADS), jnp.float32),
        "norm_ssd": 1.0 + 0.02 * nrm(ks[15], (DEPTH, E_SSD), jnp.float32),
        "ln_g": 1.0 + 0.02 * nrm(ks[16], (DEPTH, E_MLP), jnp.float32),
        "ln_b": 0.02 * nrm(ks[17], (DEPTH, E_MLP), jnp.float32),
        "w_spatial": MLP_CHUNK ** -0.5 * nrm(ks[18], (DEPTH, MLP_GROUPS, MLP_CHUNK, MLP_CHUNK), jnp.float32),
        "b_spatial": 1.0 + 0.02 * nrm(ks[19], (DEPTH, MLP_GROUPS, MLP_CHUNK), jnp.float32),
        "w_bp_ssd": E_SSD ** -0.5 * nrm(ks[20], (DEPTH, E_SSD, D_MODEL), jnp.float32),
        "w_bp_mlp": E_MLP ** -0.5 * nrm(ks[21], (DEPTH, E_MLP, D_MODEL), jnp.float32),
        "w_o": D_MODEL ** -0.5 * nrm(ks[22], (DEPTH, D_MODEL, D_MODEL), jnp.float32),
        "g_final": 1.0 + 0.02 * nrm(ks[23], (D_MODEL,), jnp.float32),
    }


def reference(x_prompt, x_sample, state_ssm, cache_conv, c_prompt, c_sample, w_ada, b_ada, g_pre,
              w_in, conv_w, conv_b, dt_bias, a_log, d_skip, norm_ssd, ln_g, ln_b, w_spatial,
              b_spatial, w_bp_ssd, w_bp_mlp, w_o, g_final):
    yp, ys = x_prompt, x_sample
    bp = x_prompt.shape[0]
    ssm_p, conv_p, ssm_s, conv_s, v_s = [], [], [], [], []
    for l in range(DEPTH):
        w = (w_ada[l], b_ada[l], g_pre[l], w_in[l], conv_w[l], conv_b[l], dt_bias[l], a_log[l],
             d_skip[l], norm_ssd[l], ln_g[l], ln_b[l], w_spatial[l], b_spatial[l],
             w_bp_ssd[l], w_bp_mlp[l], w_o[l])
        hist0 = jnp.zeros((bp, CONV_W - 1, CONV_DIM), x_prompt.dtype)
        h0 = jnp.zeros((bp, SSD_HEADS, SSD_HEAD_DIM, D_STATE), state_ssm.dtype)
        yp, hist_p, h_p, _ = _layer(yp, c_prompt, hist0, h0, *w)
        ys, hist_s, h_s, vn_s = _layer(ys, c_sample, cache_conv[l], state_ssm[l], *w)
        ssm_p.append(h_p)
        conv_p.append(hist_p)
        ssm_s.append(h_s)
        conv_s.append(hist_s)
        v_s.append(vn_s)
    y_prompt = _rmsnorm(yp, g_final)
    y_sample = _rmsnorm(ys, g_final)
    return (y_prompt, y_sample, jnp.stack(ssm_p), jnp.stack(conv_p), jnp.stack(ssm_s), jnp.stack(conv_s), jnp.stack(v_s))
```

```cpp
#include <hip/hip_runtime.h>
#include <hip/hip_cooperative_groups.h>
#include <cstdio>
#include <cstdint>
namespace cg = cooperative_groups;
#ifndef DUPK
#define DUPK -1
#endif

#define LAS __attribute__((address_space(3)))
typedef unsigned short bf16_t;
typedef short bf16x8 __attribute__((ext_vector_type(8)));
typedef float f32x4 __attribute__((ext_vector_type(4)));
typedef unsigned u32x4 __attribute__((ext_vector_type(4)));
typedef unsigned u32x2 __attribute__((ext_vector_type(2)));

constexpr int T = 8448, TP = 8192, DM = 2048, NPJ = 15360, NBT = 15616, KD = 2048;
constexpr int C_ZS = 0, C_XS = 2048, C_U = 5120, C_V = 7168, C_ZM = 9216, C_GS = 11264, C_GM = 13312;
constexpr float EPS = 1e-5f;
constexpr int LDS_BYTES = 139264;

constexpr size_t WS_WIN = 0;
constexpr size_t WS_H = 63963136;
constexpr size_t WS_S = 0;
constexpr size_t WS_PART = 0;
constexpr size_t WS_WB = 98566144;
constexpr size_t WS_PROJ = 123731968;
constexpr size_t WS_WF = 464821248;
constexpr size_t WS_AS = WS_WF + 3 * 8388608;
constexpr size_t WS_DT = 383254528;
constexpr size_t WS_EAC = 384335872;
constexpr size_t WS_YP = 385417216;
constexpr size_t WS_CPOST = 71303168;
constexpr size_t WS_MODS = 428670976;
constexpr size_t WS_BDEC = 428916736;
constexpr size_t WS_LNS = 428934144;
constexpr size_t WS_SSQ = 429001728;
constexpr size_t WS_RSS = 429136896;
constexpr size_t WS_YZ = 430218240;
constexpr size_t WS_YMLP = WS_PROJ + 34603008;
constexpr size_t WS_MRG = WS_YP;
constexpr size_t WS_BAR = 499424256;
constexpr size_t WS_CNT = WS_BAR + 16384;
constexpr size_t WS_END = 499424256 + 32768;

constexpr size_t O_Y = 0, O_SSMP = 17301504, O_CONVP = 17825792, O_SSMS = 17844224, O_CONVS = 19941376, O_VS = 20015104;

struct Params { const float* in[24]; float* out; unsigned char* ws; int ph_lo, ph_hi; };

typedef __bf16 bf16x2_t __attribute__((ext_vector_type(2)));
__device__ __forceinline__ unsigned pk2(float lo, float hi) { bf16x2_t v; v.x = (__bf16)lo; v.y = (__bf16)hi; return __builtin_bit_cast(unsigned, v); }
__device__ __forceinline__ float bflo(unsigned u) { return __uint_as_float(u << 16); }
__device__ __forceinline__ float bfhi(unsigned u) { return __uint_as_float(u & 0xffff0000u); }
__device__ __forceinline__ float silu_f(float x) { return x * __builtin_amdgcn_rcpf(1.f + __expf(-x)); }
__device__ __forceinline__ float sigm_f(float x) { return __builtin_amdgcn_rcpf(1.f + __expf(-x)); }
__device__ __forceinline__ float wave_sum(float v) {
#pragma unroll
    for (int o = 1; o < 64; o <<= 1) v += __shfl_xor(v, o);
    return v;
}
__device__ __forceinline__ f32x4 mma16(bf16x8 a, bf16x8 b, f32x4 c) { return __builtin_amdgcn_mfma_f32_16x16x32_bf16(a, b, c, 0, 0, 0); }
__device__ __forceinline__ bf16x8 rowfrag(const LAS unsigned char* base, int r0, int stride, int k0, int fr, int fq) {
    return *(const LAS bf16x8*)(base + (r0 + fr) * stride + (k0 + fq * 8) * 2);
}
__device__ __forceinline__ bf16x8 trfrag(unsigned base_addr, int k0, int n0, int stride, int lane) {
    const int g = lane >> 4, q = (lane & 15) >> 2, p = lane & 3;
    const unsigned a0 = base_addr + (unsigned)((k0 + 8 * g + q) * stride + (n0 + 4 * p) * 2);
    const unsigned a1 = a0 + 4u * (unsigned)stride;
    u32x2 r0, r1;
    asm volatile("ds_read_b64_tr_b16 %0, %2\n\tds_read_b64_tr_b16 %1, %3\n\ts_waitcnt lgkmcnt(0)" : "=&v"(r0), "=&v"(r1) : "v"(a0), "v"(a1) : "memory");
    u32x4 r; r.x = r0.x; r.y = r0.y; r.z = r1.x; r.w = r1.y;
    return __builtin_bit_cast(bf16x8, r);
}
__device__ __forceinline__ void tr8_xc(unsigned base_addr, int lane, bf16x8 (&out)[4][2]) {
    const int g = lane >> 4, q = (lane & 15) >> 2, p = lane & 3;
    const unsigned a0 = base_addr + (unsigned)((8 * g + q) * 1040 + 8 * p);
    u32x2 r[16];
    asm volatile("ds_read_b64_tr_b16 %0, %8 offset:0\n\t"
        "ds_read_b64_tr_b16 %1, %8 offset:4160\n\t"
        "ds_read_b64_tr_b16 %2, %8 offset:33280\n\t"
        "ds_read_b64_tr_b16 %3, %8 offset:37440\n\t"
        "ds_read_b64_tr_b16 %4, %8 offset:32\n\t"
        "ds_read_b64_tr_b16 %5, %8 offset:4192\n\t"
        "ds_read_b64_tr_b16 %6, %8 offset:33312\n\t"
        "ds_read_b64_tr_b16 %7, %8 offset:37472\n\t"
        "s_waitcnt lgkmcnt(0)" : "=&v"(r[0]), "=&v"(r[1]), "=&v"(r[2]), "=&v"(r[3]), "=&v"(r[4]), "=&v"(r[5]), "=&v"(r[6]), "=&v"(r[7]) : "v"(a0) : "memory");
    asm volatile("ds_read_b64_tr_b16 %0, %8 offset:64\n\t"
        "ds_read_b64_tr_b16 %1, %8 offset:4224\n\t"
        "ds_read_b64_tr_b16 %2, %8 offset:33344\n\t"
        "ds_read_b64_tr_b16 %3, %8 offset:37504\n\t"
        "ds_read_b64_tr_b16 %4, %8 offset:96\n\t"
        "ds_read_b64_tr_b16 %5, %8 offset:4256\n\t"
        "ds_read_b64_tr_b16 %6, %8 offset:33376\n\t"
        "ds_read_b64_tr_b16 %7, %8 offset:37536\n\t"
        "s_waitcnt lgkmcnt(0)" : "=&v"(r[8]), "=&v"(r[9]), "=&v"(r[10]), "=&v"(r[11]), "=&v"(r[12]), "=&v"(r[13]), "=&v"(r[14]), "=&v"(r[15]) : "v"(a0) : "memory");
#pragma unroll
    for (int a = 0; a < 4; ++a)
#pragma unroll
        for (int ks = 0; ks < 2; ++ks) { u32x4 v; v.x = r[(a * 2 + ks) * 2].x; v.y = r[(a * 2 + ks) * 2].y; v.z = r[(a * 2 + ks) * 2 + 1].x; v.w = r[(a * 2 + ks) * 2 + 1].y; out[a][ks] = __builtin_bit_cast(bf16x8, v); }
}
__device__ __forceinline__ void tr8_bm(unsigned base_addr, int lane, bf16x8 (&out)[4][2]) {
    const int g = lane >> 4, q = (lane & 15) >> 2, p = lane & 3;
    const unsigned a0 = base_addr + (unsigned)((8 * g + q) * 272 + 8 * p);
    u32x2 r[16];
    asm volatile("ds_read_b64_tr_b16 %0, %8 offset:0\n\t"
        "ds_read_b64_tr_b16 %1, %8 offset:1088\n\t"
        "ds_read_b64_tr_b16 %2, %8 offset:8704\n\t"
        "ds_read_b64_tr_b16 %3, %8 offset:9792\n\t"
        "ds_read_b64_tr_b16 %4, %8 offset:32\n\t"
        "ds_read_b64_tr_b16 %5, %8 offset:1120\n\t"
        "ds_read_b64_tr_b16 %6, %8 offset:8736\n\t"
        "ds_read_b64_tr_b16 %7, %8 offset:9824\n\t"
        "s_waitcnt lgkmcnt(0)" : "=&v"(r[0]), "=&v"(r[1]), "=&v"(r[2]), "=&v"(r[3]), "=&v"(r[4]), "=&v"(r[5]), "=&v"(r[6]), "=&v"(r[7]) : "v"(a0) : "memory");
    asm volatile("ds_read_b64_tr_b16 %0, %8 offset:64\n\t"
        "ds_read_b64_tr_b16 %1, %8 offset:1152\n\t"
        "ds_read_b64_tr_b16 %2, %8 offset:8768\n\t"
        "ds_read_b64_tr_b16 %3, %8 offset:9856\n\t"
        "ds_read_b64_tr_b16 %4, %8 offset:96\n\t"
        "ds_read_b64_tr_b16 %5, %8 offset:1184\n\t"
        "ds_read_b64_tr_b16 %6, %8 offset:8800\n\t"
        "ds_read_b64_tr_b16 %7, %8 offset:9888\n\t"
        "s_waitcnt lgkmcnt(0)" : "=&v"(r[8]), "=&v"(r[9]), "=&v"(r[10]), "=&v"(r[11]), "=&v"(r[12]), "=&v"(r[13]), "=&v"(r[14]), "=&v"(r[15]) : "v"(a0) : "memory");
#pragma unroll
    for (int a = 0; a < 4; ++a)
#pragma unroll
        for (int ks = 0; ks < 2; ++ks) { u32x4 v; v.x = r[(a * 2 + ks) * 2].x; v.y = r[(a * 2 + ks) * 2].y; v.z = r[(a * 2 + ks) * 2 + 1].x; v.w = r[(a * 2 + ks) * 2 + 1].y; out[a][ks] = __builtin_bit_cast(bf16x8, v); }
}
__device__ __forceinline__ void tr8_vn(unsigned base_addr, int lane, bf16x8 (&out)[8]) {
    const int g = lane >> 4, q = (lane & 15) >> 2, p = lane & 3;
    const unsigned a0 = base_addr + (unsigned)((8 * g + q) * 528 + 8 * p);
    u32x2 r[16];
    asm volatile("ds_read_b64_tr_b16 %0, %16 offset:0\n\t"
        "ds_read_b64_tr_b16 %1, %16 offset:2112\n\t"
        "ds_read_b64_tr_b16 %2, %16 offset:32\n\t"
        "ds_read_b64_tr_b16 %3, %16 offset:2144\n\t"
        "ds_read_b64_tr_b16 %4, %16 offset:64\n\t"
        "ds_read_b64_tr_b16 %5, %16 offset:2176\n\t"
        "ds_read_b64_tr_b16 %6, %16 offset:96\n\t"
        "ds_read_b64_tr_b16 %7, %16 offset:2208\n\t"
        "ds_read_b64_tr_b16 %8, %16 offset:128\n\t"
        "ds_read_b64_tr_b16 %9, %16 offset:2240\n\t"
        "ds_read_b64_tr_b16 %10, %16 offset:160\n\t"
        "ds_read_b64_tr_b16 %11, %16 offset:2272\n\t"
        "ds_read_b64_tr_b16 %12, %16 offset:192\n\t"
        "ds_read_b64_tr_b16 %13, %16 offset:2304\n\t"
        "ds_read_b64_tr_b16 %14, %16 offset:224\n\t"
        "ds_read_b64_tr_b16 %15, %16 offset:2336\n\t"
        "s_waitcnt lgkmcnt(0)" : "=&v"(r[0]), "=&v"(r[1]), "=&v"(r[2]), "=&v"(r[3]), "=&v"(r[4]), "=&v"(r[5]), "=&v"(r[6]), "=&v"(r[7]), "=&v"(r[8]), "=&v"(r[9]), "=&v"(r[10]), "=&v"(r[11]), "=&v"(r[12]), "=&v"(r[13]), "=&v"(r[14]), "=&v"(r[15]) : "v"(a0) : "memory");
#pragma unroll
    for (int a = 0; a < 8; ++a) { u32x4 v; v.x = r[2 * a].x; v.y = r[2 * a].y; v.z = r[2 * a + 1].x; v.w = r[2 * a + 1].y; out[a] = __builtin_bit_cast(bf16x8, v); }
}
__device__ __forceinline__ u32x4 widen16(u32x2 A, u32x2 B) {
    const auto r0 = __builtin_amdgcn_permlane16_swap(A.x, B.x, false, false);
    const auto r1 = __builtin_amdgcn_permlane16_swap(A.y, B.y, false, false);
    u32x4 o; o.x = r0[0]; o.y = r1[0]; o.z = r0[1]; o.w = r1[1]; return o;
}
__device__ __forceinline__ void unwiden16(u32x4 w, u32x2& A, u32x2& B) {
    const auto r0 = __builtin_amdgcn_permlane16_swap(w.x, w.z, false, false);
    const auto r1 = __builtin_amdgcn_permlane16_swap(w.y, w.w, false, false);
    A.x = r0[0]; A.y = r1[0]; B.x = r0[1]; B.y = r1[1];
}
__device__ __forceinline__ bf16x8 pack8(const float* m) {
    u32x4 r; r.x = pk2(m[0], m[1]); r.y = pk2(m[2], m[3]); r.z = pk2(m[4], m[5]); r.w = pk2(m[6], m[7]);
    return __builtin_bit_cast(bf16x8, r);
}
__device__ __forceinline__ size_t pj(int row, int col) { return ((size_t)(col >> 8) * T + row) * 256 + (col & 255); }
__device__ __forceinline__ size_t pjf(int row, int col) { return ((size_t)(col >> 3) * T + row) * 8 + (col & 7); }
__device__ __forceinline__ bool pn_is_frag(int pn) { return !((pn >= 8 && pn < 20) || (pn >= 28 && pn < 36)); }
__device__ __forceinline__ size_t pjs(int rl, int col) { return ((size_t)(col >> 3) * 256 + rl) * 8 + (col & 7); }
__device__ __forceinline__ int stream_of(int r) { return r < TP ? (r >> 12) : 2 + ((r - TP) >> 5); }


#define XB_TMO      128
#define XB_XCNT(j)  (256  + 64 * (j))
#define XB_XSUB(j)  (1280 + 64 * (j))
#define XB_XGEN(j)  (2304 + 64 * (j))
#define XB_TOP      3328
#define XB_TOPGEN   3392
#define XCD_BAR_WORDS 3456
#define XB_SPIN_CAP (1u << 18)
__device__ __forceinline__ unsigned xb_ld(unsigned* p)              { return __hip_atomic_load(p, __ATOMIC_RELAXED, __HIP_MEMORY_SCOPE_AGENT); }
__device__ __forceinline__ unsigned xb_add(unsigned* p, unsigned v) { return __hip_atomic_fetch_add(p, v, __ATOMIC_RELAXED, __HIP_MEMORY_SCOPE_AGENT); }
__device__ __forceinline__ unsigned xb_xcc_id() { return (unsigned)__builtin_amdgcn_s_getreg((3 << 11) | 20) & 0xFu; }
#define XB_SPIN(cond, bar) do { unsigned _sp = 0; while (cond) { __builtin_amdgcn_s_sleep(1); \
    if ((++_sp & 255u) == 0u) { if (xb_ld(&(bar)[XB_TMO])) break; if (_sp > XB_SPIN_CAP) { atomicAdd(&(bar)[XB_TMO], 1u); break; } } } } while (0)
struct XcdBarrier { unsigned* bar; unsigned x; volatile LAS unsigned* st; };
__device__ __forceinline__ XcdBarrier xcd_barrier_post(unsigned* bar, volatile LAS unsigned* st) {
    XcdBarrier b; b.bar = bar; b.x = xb_xcc_id(); b.st = st;
    if (threadIdx.x == 0) (void)xb_add(&bar[XB_XCNT(b.x)], 1u);
    return b;
}
__device__ __forceinline__ void xcd_barrier_complete(unsigned* bar, unsigned x, unsigned& nloc, unsigned& nx) {
    const unsigned G = gridDim.x * gridDim.y * gridDim.z;
    unsigned sum, cnt, mine, sp = 0u;
    for (;;) {
        sum = 0u; cnt = 0u; mine = 0u;
#pragma unroll
        for (unsigned j = 0; j < 16; ++j) { const unsigned c = xb_ld(&bar[XB_XCNT(j)]); sum += c; cnt += (c > 0u) ? 1u : 0u; mine = (j == x) ? c : mine; }
        if (sum == G) break;
        __builtin_amdgcn_s_sleep(1);
        if ((++sp & 255u) == 0u) { if (xb_ld(&bar[XB_TMO])) break; if (sp > XB_SPIN_CAP) { atomicAdd(&bar[XB_TMO], 1u); break; } }
    }
    nloc = mine > 0u ? mine : 1u; nx = cnt > 0u ? cnt : 1u;
}
__device__ __forceinline__ void xcd_barrier(const XcdBarrier& b) {
    asm volatile("s_waitcnt vmcnt(0)" ::: "memory");
    __syncthreads();
    if (threadIdx.x == 0) {
        unsigned* bar = b.bar;
        __builtin_amdgcn_s_waitcnt(0);
        unsigned nloc = b.st[0], nx = b.st[1];
        if (nloc == 0u) { xcd_barrier_complete(bar, b.x, nloc, nx); b.st[0] = nloc; b.st[1] = nx; }
        const unsigned old = xb_add(&bar[XB_XSUB(b.x)], 1u);
        const unsigned gen = old / nloc;
        if (old + 1u == (gen + 1u) * nloc) {
            __builtin_amdgcn_fence(__ATOMIC_RELEASE, "agent");
            asm volatile("s_waitcnt vmcnt(0)" ::: "memory");
            const unsigned og = xb_add(&bar[XB_TOP], 1u);
            const unsigned tg = og / nx;
            if (og + 1u == (tg + 1u) * nx) xb_add(&bar[XB_TOPGEN], 1u);
            else XB_SPIN(xb_ld(&bar[XB_TOPGEN]) == tg, bar);
            __builtin_amdgcn_fence(__ATOMIC_ACQUIRE, "agent");
            xb_add(&bar[XB_XGEN(b.x)], 1u);
            asm volatile("s_waitcnt vmcnt(0)" ::: "memory");
        } else {
            XB_SPIN(xb_ld(&bar[XB_XGEN(b.x)]) == gen, bar);
            __builtin_amdgcn_fence(__ATOMIC_ACQUIRE, "agent");
            asm volatile("s_waitcnt vmcnt(0)" ::: "memory");
        }
    }
    __syncthreads();
}

namespace pg8 {
constexpr int BM = 256, BK = 64, HALF = 128, HTB = HALF * BK * 2, STAGE_BYTES = 8 * HTB, NXCD = 8, WGM = 8;
__host__ __device__ __forceinline__ int lds_byte(int r, int c) { const int st = (r >> 4) * 2 + (c >> 5), rr = r & 15, cc = c & 31, ob = rr * 64 + cc * 2; return st * 1024 + (ob ^ (((ob >> 9) & 1) << 5)); }
__host__ __device__ __forceinline__ void stage_rc(int b, int& R, int& C) { const int st = b / 1024, sb = b % 1024, swz = sb ^ (((sb >> 9) & 1) << 5); R = (st >> 1) * 16 + swz / 64; C = (st & 1) * 32 + (swz % 64) / 2; }
__host__ __device__ __forceinline__ int perm32(int rho) { const int n = rho >> 4, i = rho & 15; return 8 * (i >> 2) + 4 * n + (i & 3); }

struct Unit { int pm, pn, w, pad; const char* a; const char* b; };

template <bool DOEPI = true, class Epi, class Sched>
__device__ __forceinline__ void gemm_phase(LAS unsigned char* lds, const int K, const int lda  , const Sched& S, const Epi& E) {
    const int tid = threadIdx.x, wid = __builtin_amdgcn_readfirstlane(tid >> 6), lane = tid & 63, wr = wid >> 2, wc = wid & 3, fr = lane & 15, fq = lane >> 4;
    const int nt = K / BK;
    unsigned voffA[2], voffB[2];
#pragma unroll
    for (int i = 0; i < 2; ++i) { int R, C; stage_rc(tid * 16 + i * 8192, R, C); const int Rb = Epi::PERM ? ((R & ~31) + perm32(R & 31)) : R;
        voffA[i] = (unsigned)(R * lda + C * 2); voffB[i] = (unsigned)(Rb * K + C) * 2u; }
    const size_t kstep = (size_t)(BK * 2);
    const size_t hstepA = (size_t)HALF * lda, hstepB = (size_t)HALF * K * 2;
    const unsigned ldsw = (unsigned)wid * 1024u;
    const int aoff = lds_byte(wr * 64 + fr, fq * 8), boff = lds_byte(wc * 32 + fr, fq * 8);
#define PG8_SA(b, h) (((b) * 2 + (h)) * HTB)
#define PG8_SB(b, h) ((4 + (b) * 2 + (h)) * HTB)
#define PG8_STAGE(bufoff, gbase, voff) do { _Pragma("unroll") for (int _i = 0; _i < 2; ++_i) \
        __builtin_amdgcn_global_load_lds((const unsigned*)((const char*)(gbase) + (voff)[_i]), (LAS unsigned*)(lds + (bufoff) + ldsw + _i * 8192), 16, 0, 0); } while (0)
#define PG8_LDA(dst, b, h) do { _Pragma("unroll") for (int m = 0; m < 4; ++m) _Pragma("unroll") for (int k = 0; k < 2; ++k) dst[m][k] = *(const LAS bf16x8*)(lds + PG8_SA(b, h) + aoff + m * 2048 + k * 1024); } while (0)
#define PG8_LDB(dst, b, h) do { _Pragma("unroll") for (int n = 0; n < 2; ++n) _Pragma("unroll") for (int k = 0; k < 2; ++k) dst[n][k] = *(const LAS bf16x8*)(lds + PG8_SB(b, h) + boff + n * 2048 + k * 1024); } while (0)
#define PG8_MMA(ai, bj, At, Bt) do { __builtin_amdgcn_s_setprio(1); _Pragma("unroll") for (int m = 0; m < 4; ++m) _Pragma("unroll") for (int n = 0; n < 2; ++n) _Pragma("unroll") for (int k = 0; k < 2; ++k) \
        acc[ai][bj][m][n] = __builtin_amdgcn_mfma_f32_16x16x32_bf16(Bt[n][k], At[m][k], acc[ai][bj][m][n], 0, 0, 0); __builtin_amdgcn_s_setprio(0); } while (0)
#define PG8_WAIT_V(n) asm volatile("s_waitcnt vmcnt(" #n ")" ::: "memory")
#define PG8_WAIT_L(n) asm volatile("s_waitcnt lgkmcnt(" #n ")" ::: "memory")
#define PG8_BAR __builtin_amdgcn_s_barrier()
#define PG8_SCHED __builtin_amdgcn_sched_barrier(0)
    Unit cur, nxt; int ui = 0;
    if (!S.next(0, cur)) return;
    f32x4 acc[2][2][4][2];
#pragma unroll
    for (int a = 0; a < 2; ++a)
#pragma unroll
        for (int b = 0; b < 2; ++b)
#pragma unroll
            for (int m = 0; m < 4; ++m)
#pragma unroll
                for (int n = 0; n < 2; ++n) acc[a][b][m][n] = (f32x4){0.f, 0.f, 0.f, 0.f};
    bf16x8 At[4][2], B0[2][2], B1[2][2];
    const char* cA = cur.a; const char* cB = cur.b;
    PG8_STAGE(PG8_SB(0, 0), cB, voffB); PG8_STAGE(PG8_SB(0, 1), cB + hstepB, voffB); PG8_STAGE(PG8_SA(0, 0), cA, voffA); PG8_STAGE(PG8_SA(0, 1), cA + hstepA, voffA);
    if (wr == 1) PG8_BAR;
    PG8_WAIT_V(2); PG8_BAR;
    PG8_STAGE(PG8_SB(1, 0), cB + kstep, voffB); PG8_STAGE(PG8_SA(1, 0), cA + kstep, voffA); PG8_STAGE(PG8_SB(1, 1), cB + hstepB + kstep, voffB);
    PG8_WAIT_V(6); PG8_BAR;
    for (;;) {
        const bool has_next = S.next(ui + 1, nxt);
        const char* nA = has_next ? nxt.a : cA; const char* nB = has_next ? nxt.b : cB;
        for (int t = 0; t < nt; t += 2) {
            const bool last = (t == nt - 2);
            const char* a1 = cA + (size_t)(t + 1) * kstep;
            const char* a2 = last ? nA : cA + (size_t)(t + 2) * kstep; const char* b2 = last ? nB : cB + (size_t)(t + 2) * kstep;
            const char* a3 = a2 + kstep; const char* b3 = b2 + kstep;
            PG8_LDB(B0, 0, 0); PG8_LDB(B1, 0, 1); PG8_SCHED; PG8_LDA(At, 0, 0); PG8_STAGE(PG8_SA(1, 1), a1 + hstepA, voffA);
            PG8_WAIT_V(8); PG8_WAIT_L(0); PG8_BAR; PG8_MMA(0, 0, At, B0); PG8_MMA(0, 1, At, B1); PG8_BAR; PG8_SCHED;
            PG8_LDA(At, 0, 1); PG8_STAGE(PG8_SB(0, 0), b2, voffB); PG8_STAGE(PG8_SB(0, 1), b2 + hstepB, voffB); PG8_STAGE(PG8_SA(0, 0), a2, voffA);
            PG8_WAIT_V(8); PG8_WAIT_L(0); PG8_BAR; PG8_MMA(1, 0, At, B0); PG8_MMA(1, 1, At, B1); PG8_BAR; PG8_SCHED;
            PG8_LDB(B0, 1, 0); PG8_LDB(B1, 1, 1); PG8_SCHED; PG8_LDA(At, 1, 0); PG8_STAGE(PG8_SA(0, 1), a2 + hstepA, voffA);
            PG8_WAIT_V(8); PG8_WAIT_L(0); PG8_BAR; PG8_MMA(0, 0, At, B0); PG8_MMA(0, 1, At, B1); PG8_BAR; PG8_SCHED;
            PG8_LDA(At, 1, 1); PG8_STAGE(PG8_SB(1, 0), b3, voffB); PG8_STAGE(PG8_SB(1, 1), b3 + hstepB, voffB); PG8_STAGE(PG8_SA(1, 0), a3, voffA);
            PG8_WAIT_V(8); PG8_WAIT_L(0); PG8_BAR; PG8_MMA(1, 0, At, B0); PG8_MMA(1, 1, At, B1); PG8_BAR; PG8_SCHED;
        }
        if (wr == 0) PG8_BAR;
        bool zacc = true;
        if (DOEPI) zacc = E(acc, cur, wr, wc, fr, fq);
        else { f32x4 t = (f32x4){0.f, 0.f, 0.f, 0.f};
#pragma unroll
            for (int a = 0; a < 2; ++a)
#pragma unroll
                for (int b = 0; b < 2; ++b)
#pragma unroll
                    for (int m = 0; m < 4; ++m)
#pragma unroll
                        for (int n = 0; n < 2; ++n) t += acc[a][b][m][n];
            if (t.x + t.y + t.z + t.w == 123456.789f) *(volatile float*)cur.a = 0.f; }
        if (!has_next) break;
        if (zacc) {
#pragma unroll
        for (int a = 0; a < 2; ++a)
#pragma unroll
            for (int b = 0; b < 2; ++b)
#pragma unroll
                for (int m = 0; m < 4; ++m)
#pragma unroll
                    for (int n = 0; n < 2; ++n) acc[a][b][m][n] = (f32x4){0.f, 0.f, 0.f, 0.f};
        }
        cur = nxt; cA = nA; cB = nB; ++ui;
        if (wr == 1) PG8_BAR;
    }
    PG8_WAIT_V(0);
    PG8_BAR;
#undef PG8_SA
#undef PG8_SB
#undef PG8_STAGE
#undef PG8_LDA
#undef PG8_LDB
#undef PG8_MMA
#undef PG8_WAIT_V
#undef PG8_WAIT_L
#undef PG8_BAR
#undef PG8_SCHED
}
}
using pg8::Unit;

__device__ __forceinline__ void phase0(const Params& P, LAS unsigned char* lds) {
    const int tid = threadIdx.x, lane = tid & 63, wave = tid >> 6;
    float* mods = (float*)(P.ws + WS_MODS);
    if (blockIdx.x < 192) {
        LAS float* sc = (LAS float*)lds;
        LAS float* red = (LAS float*)(lds + 81920);
        for (int i = tid; i < 10 * 2048; i += 512) { const int s = i >> 11, k = i & 2047; const float c = s < 2 ? P.in[4][s * 2048 + k] : P.in[5][(s - 2) * 2048 + k]; sc[i] = silu_f(c); }
        __syncthreads();
        for (int cb = blockIdx.x; cb < 192; cb += gridDim.x) {
            const int cgp = tid & 7, ksl = tid >> 3, j = cb * 32 + cgp * 4;
            f32x4 acc[10];
#pragma unroll
            for (int s = 0; s < 10; ++s) acc[s] = (f32x4){0.f, 0.f, 0.f, 0.f};
            const float* w = P.in[6] + j;
#pragma unroll 8
            for (int i = 0; i < 32; ++i) { const int k = ksl + 64 * i; const f32x4 wv = *(const f32x4*)(w + (size_t)k * 6144);
#pragma unroll
                for (int s = 0; s < 10; ++s) acc[s] += wv * sc[s * 2048 + k]; }
#pragma unroll
            for (int s = 0; s < 10; ++s)
#pragma unroll
                for (int e = 0; e < 4; ++e) { float v = acc[s][e]; v += __shfl_xor(v, 8); v += __shfl_xor(v, 16); v += __shfl_xor(v, 32); acc[s][e] = v; }
            if (lane < 8) {
#pragma unroll
                for (int s = 0; s < 10; ++s) *(LAS f32x4*)(red + (wave * 10 + s) * 32 + cgp * 4) = acc[s]; }
            __syncthreads();
            if (tid < 320) { const int s = tid >> 5, jj = tid & 31; float v = 0.f;
#pragma unroll
                for (int q = 0; q < 8; ++q) v += red[(q * 10 + s) * 32 + jj];
                mods[s * 6144 + cb * 32 + jj] = v + P.in[7][cb * 32 + jj]; }
            asm volatile("s_waitcnt vmcnt(0)" ::: "memory");
            __syncthreads();
            if (tid == 0) { __builtin_amdgcn_fence(__ATOMIC_RELEASE, "agent"); asm volatile("s_waitcnt vmcnt(0)" ::: "memory"); xb_add((unsigned*)(P.ws + WS_CNT) + 64 * 48, 1u); }
        }
    }
    __syncthreads();
    LAS float* scr = (LAS float*)(lds + wave * 8448);
    const int gw = blockIdx.x * 8 + wave, NGW = gridDim.x * 8;
    constexpr int I_IN = 32 * 488, I_SQ = 32 * 64, NIT = I_IN + 3 * I_SQ;
    bf16_t* Win = (bf16_t*)(P.ws + WS_WIN); bf16_t* Wb = (bf16_t*)(P.ws + WS_WB);
    struct TItem { const float* src; const float* ksc; bf16_t* dst; bf16_t* dstf; int ldw; int zero; };
    auto decode = [&](int it, TItem& t) {
        const float* W; int ldw, nbsrc, nbdst, kb; bf16_t* dst; const float* ksc = nullptr;
        if (it < I_IN) { kb = it / 488; nbdst = it % 488; nbsrc = nbdst < 160 ? nbdst : (nbdst < 480 ? nbdst + 1 : (nbdst == 480 ? 160 : -1)); W = P.in[9]; ldw = 15392; dst = Win; }
        else { int r = it - I_IN; const int m = r / I_SQ; r -= m * I_SQ; kb = r / 64; nbdst = r % 64; nbsrc = nbdst; ldw = 2048; W = m == 0 ? P.in[20] : (m == 1 ? P.in[21] : P.in[22]); dst = Wb + (size_t)m * 2048 * 2048; if (m == 0) ksc = P.in[15]; }
        t.zero = nbsrc < 0; t.ldw = ldw; t.ksc = ksc ? ksc + kb * 64 : nullptr;
        t.src = W + (size_t)(kb * 64) * ldw + (t.zero ? 0 : nbsrc * 32);
        t.dst = dst + (size_t)(nbdst * 32) * KD + kb * 64;
        t.dstf = it < I_IN ? nullptr : (bf16_t*)(P.ws + WS_WF) + (size_t)((it - I_IN) / I_SQ) * 2048 * 2048 + ((size_t)(kb * 8) * 2048 + nbdst * 32) * 8;
    };
    auto issue = [&](const TItem& t, f32x4 (&v)[8]) {
#pragma unroll
        for (int i = 0; i < 8; ++i) { const int kk = 8 * i + (lane >> 3), nn = (lane & 7) * 4; v[i] = *(const f32x4*)(t.src + (size_t)kk * t.ldw + nn); }
    };
    const int c8 = lane & 7;
    TItem cur; f32x4 v[8];
    int it = gw;
    if (it < NIT) { decode(it, cur); issue(cur, v); }
    while (it < NIT) {
        const int itn = it + NGW; TItem nxt = cur; f32x4 vn[8];
        if (itn < NIT) { decode(itn, nxt); issue(nxt, vn); }
        else {
#pragma unroll
            for (int i = 0; i < 8; ++i) vn[i] = (f32x4){0.f, 0.f, 0.f, 0.f}; }
#pragma unroll
        for (int i = 0; i < 8; ++i) { const int kk = 8 * i + (lane >> 3), nn = (lane & 7) * 4; f32x4 x = v[i]; if (cur.ksc) x = x * cur.ksc[kk]; if (cur.zero) x = (f32x4){0.f, 0.f, 0.f, 0.f};
            scr[kk * 33 + nn] = x.x; scr[kk * 33 + nn + 1] = x.y; scr[kk * 33 + nn + 2] = x.z; scr[kk * 33 + nn + 3] = x.w; }
        asm volatile("s_waitcnt lgkmcnt(0)" ::: "memory");
#pragma unroll
        for (int j = 0; j < 4; ++j) { const int n = (lane >> 3) + 8 * j; const LAS float* sp = scr + (8 * c8) * 33 + n;
            u32x4 o; o.x = pk2(sp[0 * 33], sp[1 * 33]); o.y = pk2(sp[2 * 33], sp[3 * 33]); o.z = pk2(sp[4 * 33], sp[5 * 33]); o.w = pk2(sp[6 * 33], sp[7 * 33]);
            *(u32x4*)(cur.dst + (size_t)n * KD + 8 * c8) = o;
            if (cur.dstf) *(u32x4*)(cur.dstf + ((size_t)c8 * 2048 + n) * 8) = o; }
        asm volatile("s_waitcnt lgkmcnt(0)" ::: "memory");
        cur = nxt; it = itn;
#pragma unroll
        for (int i = 0; i < 8; ++i) v[i] = vn[i];
    }
}

__device__ __forceinline__ void phase1(const Params& P) {
    const int tid = threadIdx.x, lane = tid & 63, wave = tid >> 6;
    if (tid == 0) { unsigned* c = (unsigned*)(P.ws + WS_CNT) + 64 * 48; unsigned sp = 0u;
        while (xb_ld(c) < 192u) { __builtin_amdgcn_s_sleep(1); if (++sp > (1u << 22)) break; }
        __builtin_amdgcn_fence(__ATOMIC_ACQUIRE, "agent"); asm volatile("s_waitcnt vmcnt(0)" ::: "memory"); }
    __syncthreads();
    const int gw = blockIdx.x * 8 + wave, NGW = gridDim.x * 8;
    const float* mods = (const float*)(P.ws + WS_MODS); bf16_t* H = (bf16_t*)(P.ws + WS_H);
    auto xrow = [&](int r) { return r < TP ? P.in[0] + (size_t)r * DM : P.in[1] + (size_t)(r - TP) * DM; };
    f32x4 v[8];
    if (gw < T) { const float* xr = xrow(gw);
#pragma unroll
        for (int j = 0; j < 8; ++j) v[j] = ((const f32x4*)xr)[2 * lane + (j & 1) + 128 * (j >> 1)]; }
    for (int r = gw; r < T; r += NGW) {
        const int s = stream_of(r);
        f32x4 vn[8];
        if (r + NGW < T) { const float* xn = xrow(r + NGW);
#pragma unroll
            for (int j = 0; j < 8; ++j) vn[j] = ((const f32x4*)xn)[2 * lane + (j & 1) + 128 * (j >> 1)]; }
        else {
#pragma unroll
            for (int j = 0; j < 8; ++j) vn[j] = (f32x4){0.f, 0.f, 0.f, 0.f}; }
        float ss = 0.f;
#pragma unroll
        for (int j = 0; j < 8; ++j) ss += (v[j].x * v[j].x + v[j].y * v[j].y) + (v[j].z * v[j].z + v[j].w * v[j].w);
        ss = wave_sum(ss);
        const float rstd = rsqrtf(ss * (1.f / DM) + EPS);
        const float* ms = mods + s * 6144;
#pragma unroll
        for (int jj = 0; jj < 4; ++jj) { u32x4 o;
#pragma unroll
            for (int k2 = 0; k2 < 2; ++k2) { const int j = 2 * jj + k2, col = (2 * lane + k2 + 128 * jj) * 4;
                const f32x4 g = *(const f32x4*)(P.in[8] + col), sh = *(const f32x4*)(ms + col), sl = *(const f32x4*)(ms + 2048 + col);
                const f32x4 h = v[j] * rstd * g * (sl + 1.f) + sh;
                if (k2 == 0) { o.x = pk2(h.x, h.y); o.y = pk2(h.z, h.w); } else { o.z = pk2(h.x, h.y); o.w = pk2(h.z, h.w); } }
            *(u32x4*)(H + (size_t)r * DM + (2 * lane + 128 * jj) * 4) = o; }
#pragma unroll
        for (int j = 0; j < 8; ++j) v[j] = vn[j];
    }
}

struct SchedIn {
    int nM, nN, nwg, G, c; const char* A; const char* B;
    __device__ __forceinline__ bool next(int i, Unit& u) const {
        const long L = (long)i * G + c; if (L >= nwg) return false;
        int wgid = (int)L; { const int q = nwg / 8, r = nwg % 8, xcd = wgid % 8, off = wgid / 8; wgid = (xcd < r ? xcd * (q + 1) : r * (q + 1) + (xcd - r) * q) + off; }
        const int nig = 8 * nN, gid = wgid / nig, fm = gid * 8, gsz = (nM - fm) < 8 ? (nM - fm) : 8;
        u.pm = fm + ((wgid % nig) % gsz); u.pn = (wgid % nig) / gsz; u.w = 0; u.pad = 0;
        u.a = A + (size_t)u.pm * 256 * (KD * 2); u.b = B + (size_t)u.pn * 256 * (KD * 2); return true;
    }
};
struct EpiIn {
    static constexpr bool PERM = true;
    bf16_t* proj; float* dt; const float* dt_bias;
    __device__ __forceinline__ bool operator()(const f32x4 (&acc)[2][2][4][2], const Unit& u, int wr, int wc, int fr, int fq) const {
        const int row0 = u.pm * 256 + wr * 64 + fr;
        if (u.pn < 60) {
            const int col0 = u.pn * 256 + wc * 32 + 8 * fq; const bool frag = pn_is_frag(u.pn);
#pragma unroll
            for (int ai = 0; ai < 2; ++ai)
#pragma unroll
                for (int m = 0; m < 4; ++m) { const int row = row0 + ai * 128 + m * 16;
#pragma unroll
                    for (int bj = 0; bj < 2; ++bj) { const f32x4 v0 = acc[ai][bj][m][0], v1 = acc[ai][bj][m][1];
                        u32x4 w; w.x = pk2(v0[0], v0[1]); w.y = pk2(v0[2], v0[3]); w.z = pk2(v1[0], v1[1]); w.w = pk2(v1[2], v1[3]);
                        *(u32x4*)(proj + (frag ? pjf(row, col0 + bj * 128) : pj(row, col0 + bj * 128))) = w; } }
        } else if (wc == 0) {
            const f32x4 b0 = *(const f32x4*)(dt_bias + 8 * fq), b1 = *(const f32x4*)(dt_bias + 8 * fq + 4);
#pragma unroll
            for (int ai = 0; ai < 2; ++ai)
#pragma unroll
                for (int m = 0; m < 4; ++m) { float* dp = dt + (size_t)(row0 + ai * 128 + m * 16) * 32 + 8 * fq;
                    f32x4 v0 = acc[ai][0][m][0] + b0, v1 = acc[ai][0][m][1] + b1;
#pragma unroll
                    for (int e = 0; e < 4; ++e) { v0[e] = v0[e] > 20.f ? v0[e] : __logf(1.f + __expf(v0[e])); v1[e] = v1[e] > 20.f ? v1[e] : __logf(1.f + __expf(v1[e])); }
                    *(f32x4*)dp = v0; *(f32x4*)(dp + 4) = v1; }
        }
        return true;
    }
};


template <bool SAMP>
__device__ __forceinline__ void conv16(const u32x4 (&raw)[19], const f32x4 (&hs)[3][2], const float (&w)[4][8], const float (&bias)[8], int j0, bool zero_hist, int nv,
                                       LAS unsigned char* dst, int dstride, bool wr_state, float* cst) {
    float win[4][8];
#pragma unroll
    for (int r = 0; r < 19; ++r) {
        const int j = j0 + r - 3;
        const u32x4 q = raw[r];
        float* cur = win[r & 3];
        cur[0] = bflo(q.x); cur[1] = bfhi(q.x); cur[2] = bflo(q.y); cur[3] = bfhi(q.y); cur[4] = bflo(q.z); cur[5] = bfhi(q.z); cur[6] = bflo(q.w); cur[7] = bfhi(q.w);
        if (r < 3) {
            const bool hz = j < 0 && zero_hist;
            if (SAMP) { const bool hh = j < 0;
                cur[0] = hh ? hs[r < 3 ? r : 0][0].x : cur[0]; cur[1] = hh ? hs[r < 3 ? r : 0][0].y : cur[1]; cur[2] = hh ? hs[r < 3 ? r : 0][0].z : cur[2]; cur[3] = hh ? hs[r < 3 ? r : 0][0].w : cur[3];
                cur[4] = hh ? hs[r < 3 ? r : 0][1].x : cur[4]; cur[5] = hh ? hs[r < 3 ? r : 0][1].y : cur[5]; cur[6] = hh ? hs[r < 3 ? r : 0][1].z : cur[6]; cur[7] = hh ? hs[r < 3 ? r : 0][1].w : cur[7]; }
            else {
#pragma unroll
                for (int e = 0; e < 8; ++e) cur[e] = hz ? 0.f : cur[e]; }
        }
        if (SAMP) { const bool oob = j >= nv;
#pragma unroll
            for (int e = 0; e < 8; ++e) cur[e] = oob ? 0.f : cur[e]; }
        if (r >= 3) {
            const float* p3 = win[(r - 3) & 3]; const float* p2 = win[(r - 2) & 3]; const float* p1 = win[(r - 1) & 3];
            float o[8];
#pragma unroll
            for (int e = 0; e < 8; ++e) { const float t = __builtin_fmaf(w[3][e], cur[e], __builtin_fmaf(w[2][e], p1[e], __builtin_fmaf(w[1][e], p2[e], __builtin_fmaf(w[0][e], p3[e], bias[e]))));
                o[e] = silu_f(t); if (SAMP) o[e] = j < nv ? o[e] : 0.f; }
            u32x4 pk; pk.x = pk2(o[0], o[1]); pk.y = pk2(o[2], o[3]); pk.z = pk2(o[4], o[5]); pk.w = pk2(o[6], o[7]);
            *(LAS u32x4*)(dst + j * dstride) = pk;
            if (wr_state) { if (j >= nv - 3 && j < nv) { float* d = cst + (size_t)(j - (nv - 3)) * 3072;
                    *(f32x4*)d = (f32x4){cur[0], cur[1], cur[2], cur[3]}; *(f32x4*)(d + 4) = (f32x4){cur[4], cur[5], cur[6], cur[7]}; } }
        }
    }
}
constexpr int A_XC = 0, A_XCS = 1040, A_BM = 66560, A_CM = 83968, A_ST = 272, A_CBF = 101376, A_DTL = 118784, A_ACU = 120832;
__device__ __forceinline__ void ssd_item(const Params& P, LAS unsigned char* lds, unsigned ldsaddr, int ck, int g) {
    int tid_ = threadIdx.x; asm volatile("" : "+v"(tid_));
    const int tid = tid_, lane = tid & 63, wave = __builtin_amdgcn_readfirstlane(tid >> 6), fr = lane & 15, fq = lane >> 4;
    const bool samp = ck >= 128;
    int row0, nv, c, sidx;
    if (!samp) { sidx = ck >> 6; c = ck & 63; row0 = sidx * 4096 + c * 64; nv = 64; } else { sidx = ck - 128; c = 0; row0 = TP + sidx * 32; nv = 32; }
    const bf16_t* proj = (const bf16_t*)(P.ws + WS_PROJ);
    const float* DT = (const float*)(P.ws + WS_DT); float* EAC = (float*)(P.ws + WS_EAC); float* BDEC = (float*)(P.ws + WS_BDEC);
    bf16_t* YP = (bf16_t*)(P.ws + WS_YP); bf16_t* CPOST = (bf16_t*)(P.ws + WS_CPOST); bf16_t* S = (bf16_t*)(P.ws + WS_S);
    LAS float* DTL = (LAS float*)(lds + A_DTL); LAS float* ACU = (LAS float*)(lds + A_ACU);
    const bool act = tid < 384;
    {
        const int tcl = act ? tid : tid - 384;
        const int cg = tcl % 96, seg = tcl / 96, j0 = seg * 16;
        int ch0, dstoff, dstride;
        if (cg < 64) { ch0 = g * 512 + cg * 8; dstoff = A_XC + cg * 16; dstride = A_XCS; }
        else if (cg < 80) { ch0 = 2048 + g * 128 + (cg - 64) * 8; dstoff = A_BM + (cg - 64) * 16; dstride = A_ST; }
        else { ch0 = 2560 + g * 128 + (cg - 80) * 8; dstoff = A_CM + (cg - 80) * 16; dstride = A_ST; }
        float w[4][8], bias[8];
#pragma unroll
        for (int k = 0; k < 4; ++k) { const f32x4 a = *(const f32x4*)(P.in[10] + k * 3072 + ch0), b = *(const f32x4*)(P.in[10] + k * 3072 + ch0 + 4);
            w[k][0] = a.x; w[k][1] = a.y; w[k][2] = a.z; w[k][3] = a.w; w[k][4] = b.x; w[k][5] = b.y; w[k][6] = b.z; w[k][7] = b.w; }
        { const f32x4 a = *(const f32x4*)(P.in[11] + ch0), b = *(const f32x4*)(P.in[11] + ch0 + 4);
            bias[0] = a.x; bias[1] = a.y; bias[2] = a.z; bias[3] = a.w; bias[4] = b.x; bias[5] = b.y; bias[6] = b.z; bias[7] = b.w; }
        float p3[8], p2[8], p1[8];
#pragma unroll
        for (int e = 0; e < 8; ++e) { p3[e] = 0.f; p2[e] = 0.f; p1[e] = 0.f; }
        const bf16_t* src = proj + pj(row0, C_XS + ch0);
        const bool wr_state = samp || c == 63;
        float* cst = samp ? P.out + O_CONVS + (size_t)sidx * 3 * 3072 + ch0 : P.out + O_CONVP + (size_t)sidx * 3 * 3072 + ch0;
        u32x4 raw[19];
#pragma unroll
        for (int r = 0; r < 19; ++r) { const int j = j0 + r - 3; int jc = j < nv ? j : nv - 1; if ((samp || c == 0) && jc < 0) jc = 0; raw[r] = act ? *(const u32x4*)(src + (long)jc * 256) : (u32x4){0u, 0u, 0u, 0u}; }
        f32x4 hs[3][2];
#pragma unroll
        for (int r = 0; r < 3; ++r) { hs[r][0] = hs[r][1] = (f32x4){0.f, 0.f, 0.f, 0.f}; }
        if (samp) {
#pragma unroll
            for (int r = 0; r < 3; ++r) { const float* hp = P.in[3] + ((size_t)sidx * 3 + r) * 3072 + ch0; hs[r][0] = *(const f32x4*)hp; hs[r][1] = *(const f32x4*)(hp + 4); } }
        if (!act) {
            float dtv[4];
#pragma unroll
            for (int hq = 0; hq < 4; ++hq) { const int h = g * 8 + (wave - 6) * 4 + hq; dtv[hq] = lane < nv ? DT[(size_t)(row0 + lane) * 32 + h] : 0.f; }
#pragma unroll
            for (int hq = 0; hq < 4; ++hq) {
                const int hh = (wave - 6) * 4 + hq, h = g * 8 + hh, j = lane;
                const float dt = dtv[hq];
                const float a = -expf(P.in[13][h]);
                float x = dt * a;
#pragma unroll
                for (int o = 1; o < 64; o <<= 1) { const float y = __shfl_up(x, o); if (lane >= o) x += y; }
                DTL[hh * 64 + j] = dt; ACU[hh * 64 + j] = x;
                if (j < nv) EAC[(size_t)(row0 + j) * 32 + h] = __expf(x);
                const float last = __shfl(x, 63);
                if (lane == 0) BDEC[ck * 32 + h] = __expf(last);
            }
        }
        if (act) {
            if (samp) conv16<true>(raw, hs, w, bias, j0, false, nv, lds + dstoff, dstride, true, cst);
            else conv16<false>(raw, hs, w, bias, j0, c == 0, nv, lds + dstoff, dstride, wr_state, cst);
        }
    }
    __syncthreads();
    for (int q = tid; q < 1024; q += 512) { const int j = q & 63, n8 = q >> 6;
        if (j < nv) *(u32x4*)(CPOST + (size_t)(ck * 4 + g) * 8192 + (n8 * 64 + j) * 8) = *(const LAS u32x4*)(lds + A_CM + j * A_ST + n8 * 16); }
    for (int t2 = wave; t2 < 16; t2 += 8) {
        const int it = t2 >> 2, jt = t2 & 3;
        if (jt > it) continue;
        f32x4 acc = (f32x4){0.f, 0.f, 0.f, 0.f};
#pragma unroll
        for (int ks = 0; ks < 4; ++ks) { const bf16x8 a = rowfrag(lds + A_BM, jt * 16, A_ST, ks * 32, fr, fq), b = rowfrag(lds + A_CM, it * 16, A_ST, ks * 32, fr, fq); acc = mma16(a, b, acc); }
        *(LAS f32x4*)(lds + A_CBF + (it * 16 + fr) * 272 + (jt * 16 + fq * 4) * 4) = acc;
    }
    __syncthreads();
    {
        const int hh = wave, h = g * 8 + hh; const float dsk = P.in[14][h];
        bf16x8 xf[4][2];
        tr8_xc(ldsaddr + A_XC + hh * 128, lane, xf);
        float wj[2][8];
        const float alast = ACU[hh * 64 + 63];
#pragma unroll
        for (int ks = 0; ks < 2; ++ks) { const int jb = ks * 32 + fq * 8;
            const f32x4 aj0 = *(const LAS f32x4*)(ACU + hh * 64 + jb), aj1 = *(const LAS f32x4*)(ACU + hh * 64 + jb + 4);
            const f32x4 dt0 = *(const LAS f32x4*)(DTL + hh * 64 + jb), dt1 = *(const LAS f32x4*)(DTL + hh * 64 + jb + 4);
            wj[ks][0] = dt0.x * __expf(alast - aj0.x); wj[ks][1] = dt0.y * __expf(alast - aj0.y); wj[ks][2] = dt0.z * __expf(alast - aj0.z); wj[ks][3] = dt0.w * __expf(alast - aj0.w);
            wj[ks][4] = dt1.x * __expf(alast - aj1.x); wj[ks][5] = dt1.y * __expf(alast - aj1.y); wj[ks][6] = dt1.z * __expf(alast - aj1.z); wj[ks][7] = dt1.w * __expf(alast - aj1.w); }
#pragma unroll
        for (int it = 0; it < 4; ++it) {
            if (it * 16 >= nv) break;
            const int i = it * 16 + fr; const float ai = ACU[hh * 64 + i];
            f32x4 ya[4];
#pragma unroll
            for (int pt = 0; pt < 4; ++pt) ya[pt] = (f32x4){0.f, 0.f, 0.f, 0.f};
#pragma unroll
            for (int ks = 0; ks < 2; ++ks) {
                if (ks * 32 > it * 16 + 15) continue;
                const int jb = ks * 32 + fq * 8;
                const f32x4 aj0 = *(const LAS f32x4*)(ACU + hh * 64 + jb), aj1 = *(const LAS f32x4*)(ACU + hh * 64 + jb + 4);
                const f32x4 dt0 = *(const LAS f32x4*)(DTL + hh * 64 + jb), dt1 = *(const LAS f32x4*)(DTL + hh * 64 + jb + 4);
                const f32x4 cb0 = *(const LAS f32x4*)(lds + A_CBF + i * 272 + jb * 4), cb1 = *(const LAS f32x4*)(lds + A_CBF + i * 272 + jb * 4 + 16);
                const float aj[8] = {aj0.x, aj0.y, aj0.z, aj0.w, aj1.x, aj1.y, aj1.z, aj1.w};
                const float dj[8] = {dt0.x, dt0.y, dt0.z, dt0.w, dt1.x, dt1.y, dt1.z, dt1.w};
                const float cb[8] = {cb0.x, cb0.y, cb0.z, cb0.w, cb1.x, cb1.y, cb1.z, cb1.w};
                float m[8];
#pragma unroll
                for (int e = 0; e < 8; ++e) { const int j = jb + e; float v = (j <= i) ? cb[e] * __expf(ai - aj[e]) * dj[e] : 0.f; if (j == i) v += dsk; m[e] = v; }
                const bf16x8 mf = pack8(m);
#pragma unroll
                for (int pt = 0; pt < 4; ++pt) ya[pt] = mma16(xf[pt][ks], mf, ya[pt]);
            }
#pragma unroll
            for (int pp = 0; pp < 2; ++pp) { u32x4 o; o.x = pk2(ya[2 * pp][0], ya[2 * pp][1]); o.y = pk2(ya[2 * pp][2], ya[2 * pp][3]); o.z = pk2(ya[2 * pp + 1][0], ya[2 * pp + 1][1]); o.w = pk2(ya[2 * pp + 1][2], ya[2 * pp + 1][3]);
                *(u32x4*)(YP + (size_t)(ck * 32 + h) * 4096 + ((pp * 4 + fq) * 64 + i) * 8) = o; }
        }
#pragma unroll
        for (int pt = 0; pt < 4; ++pt)
#pragma unroll
            for (int ks = 0; ks < 2; ++ks) { const u32x4 xu = __builtin_bit_cast(u32x4, xf[pt][ks]);
                float xs[8] = {bflo(xu.x) * wj[ks][0], bfhi(xu.x) * wj[ks][1], bflo(xu.y) * wj[ks][2], bfhi(xu.y) * wj[ks][3], bflo(xu.z) * wj[ks][4], bfhi(xu.z) * wj[ks][5], bflo(xu.w) * wj[ks][6], bfhi(xu.w) * wj[ks][7]};
                xf[pt][ks] = pack8(xs); }
        bf16_t* sp = S + (size_t)(ck * 32 + h) * 8192;
#pragma unroll
        for (int nh = 0; nh < 2; ++nh) {
            bf16x8 bfr[4][2];
            tr8_bm(ldsaddr + A_BM + nh * 128, lane, bfr);
#pragma unroll
            for (int np = 0; np < 2; ++np)
#pragma unroll
                for (int pt = 0; pt < 4; ++pt) { u32x2 oo[2];
#pragma unroll
                    for (int k2 = 0; k2 < 2; ++k2) { const int nt = 2 * np + k2; f32x4 sa = mma16(bfr[nt][0], xf[pt][0], (f32x4){0.f, 0.f, 0.f, 0.f}); sa = mma16(bfr[nt][1], xf[pt][1], sa);
                        oo[k2].x = pk2(sa[0], sa[1]); oo[k2].y = pk2(sa[2], sa[3]); }
                    const u32x4 w = widen16(oo[0], oo[1]);
                    *(u32x4*)(sp + (((nh * 4 + 2 * np + (fq & 1)) * 2 + (fq >> 1)) * 64 + pt * 16 + fr) * 8) = w; }
        }
    }
    __syncthreads();
}
__device__ __forceinline__ void ln_item(const Params& P, int idx) {
    const int tid = threadIdx.x, lane = tid & 63, wave = tid >> 6;
    const bf16_t* proj = (const bf16_t*)(P.ws + WS_PROJ); float* LNS = (float*)(P.ws + WS_LNS);
    for (int q = 0; q < 5; ++q) {
        const int r = idx * 38 + wave + 8 * q;
        if (r >= T || r >= (idx + 1) * 38) break;
        u32x4 raw[4]; float s = 0.f;
#pragma unroll
        for (int j = 0; j < 4; ++j) { raw[j] = *(const u32x4*)(proj + pj(r, C_V + (lane + 64 * j) * 8)); s += (bflo(raw[j].x) + bfhi(raw[j].x)) + (bflo(raw[j].y) + bfhi(raw[j].y)) + (bflo(raw[j].z) + bfhi(raw[j].z)) + (bflo(raw[j].w) + bfhi(raw[j].w)); }
        const float mean = wave_sum(s) * (1.f / 2048.f); float s2 = 0.f;
#pragma unroll
        for (int j = 0; j < 4; ++j) { float d;
            d = bflo(raw[j].x) - mean; s2 += d * d; d = bfhi(raw[j].x) - mean; s2 += d * d; d = bflo(raw[j].y) - mean; s2 += d * d; d = bfhi(raw[j].y) - mean; s2 += d * d;
            d = bflo(raw[j].z) - mean; s2 += d * d; d = bfhi(raw[j].z) - mean; s2 += d * d; d = bflo(raw[j].w) - mean; s2 += d * d; d = bfhi(raw[j].w) - mean; s2 += d * d; }
        const float rstd = rsqrtf(wave_sum(s2) * (1.f / 2048.f) + EPS);
        if (lane == 0) { LNS[r * 2] = mean; LNS[r * 2 + 1] = rstd; }
    }
}
__device__ __forceinline__ void phase3(const Params& P, LAS unsigned char* lds, unsigned ldsaddr) {
#if DUPK == 31
    for (int it = blockIdx.x; it < 132; it += gridDim.x) ln_item(P, it);
#endif
#if DUPK == 32
    for (int it = blockIdx.x; it < 544; it += gridDim.x) ssd_item(P, lds, ldsaddr, it >> 2, it & 3);
#endif
    for (int it = blockIdx.x; it < 544 + 224; it += gridDim.x) {
        if (it < 544) ssd_item(P, lds, ldsaddr, it >> 2, it & 3); else ln_item(P, it - 544);
    }
}

template <bool DRY> __device__ __forceinline__ void scan_prompt_item(const Params& P, int item) {
    const int idx = item * 512 + threadIdx.x, n4 = idx & 31, p = (idx >> 5) & 63, h = (idx >> 11) & 31, s = idx >> 16;
    bf16_t* S = (bf16_t*)(P.ws + WS_S); bf16_t* SD = DRY ? (bf16_t*)(P.ws + WS_YZ) : S; const float* BDEC = (const float*)(P.ws + WS_BDEC);
    f32x4 hst = (f32x4){0.f, 0.f, 0.f, 0.f};
    bf16_t* sp0 = S + ((size_t)(s * 64 * 32 + h) * 64 + p) * 128 + n4 * 4;
    const float* bd0 = BDEC + (s * 64) * 32 + h;
    u32x2 raw[2][16]; float d[2][16];
#pragma unroll
    for (int q = 0; q < 16; ++q) { raw[0][q] = *(const u32x2*)(sp0 + (size_t)q * 262144); d[0][q] = bd0[q * 32]; }
#pragma unroll
    for (int b = 0; b < 4; ++b) {
        if (b < 3) {
#pragma unroll
            for (int q = 0; q < 16; ++q) { raw[(b + 1) & 1][q] = *(const u32x2*)(sp0 + (size_t)((b + 1) * 16 + q) * 262144); d[(b + 1) & 1][q] = bd0[((b + 1) * 16 + q) * 32]; } }
#pragma unroll
        for (int q = 0; q < 16; ++q) {
            u32x2 o; o.x = pk2(hst.x, hst.y); o.y = pk2(hst.z, hst.w);
            bf16_t* dst = DRY ? SD + (((size_t)((s * 64 + b * 16 + q) * 32 + h) * 64 + p) * 128 + n4 * 4) % (size_t)16777216 : sp0 + (size_t)(b * 16 + q) * 262144;
            *(u32x2*)dst = o;
            const u32x2 rr = raw[b & 1][q];
            const f32x4 sv = (f32x4){bflo(rr.x), bfhi(rr.x), bflo(rr.y), bfhi(rr.y)};
            hst = hst * d[b & 1][q] + sv; }
    }
    { const int f = p * 128 + n4 * 4, nb = f >> 9, pp = (f >> 3) & 63, e0 = f & 7;
      if (!DRY) *(f32x4*)(P.out + O_SSMP + ((size_t)(s * 32 + h) * 64 + pp) * 128 + nb * 8 + e0) = hst;
      else if (hst.x == 1.2345f) P.out[0] = 0.f; }
}
__device__ __forceinline__ void scan_sample_item(const Params& P, int item) {
    const bf16_t* S = (const bf16_t*)(P.ws + WS_S); const float* BDEC = (const float*)(P.ws + WS_BDEC);
#pragma unroll
    for (int q = 0; q < 4; ++q) {
        const int e = item * 512 + threadIdx.x + q * 131072, n4 = e & 31, p = (e >> 5) & 63, h = (e >> 11) & 31, sb = e >> 16;
        const int f = p * 128 + n4 * 4, nb = f >> 9, pp = (f >> 3) & 63, e0 = f & 7;
        const size_t off = ((size_t)(sb * 32 + h) * 64 + pp) * 128 + nb * 8 + e0;
        const f32x4 h0 = *(const f32x4*)(P.in[2] + off);
        const int ck = 128 + sb;
        const u32x2 raw = *(const u32x2*)(S + ((size_t)(ck * 32 + h) * 64 + p) * 128 + n4 * 4);
        const float d = BDEC[ck * 32 + h];
        const f32x4 sv = (f32x4){bflo(raw.x), bfhi(raw.x), bflo(raw.y), bfhi(raw.y)};
        *(f32x4*)(P.out + O_SSMS + off) = h0 * d + sv;
    }
}
__device__ __forceinline__ void wf_item(const Params& P, LAS unsigned char* lds, int m, int nb) {
    int tid = threadIdx.x; asm volatile("" : "+v"(tid));
    const u32x4* src = (const u32x4*)((const bf16_t*)(P.ws + WS_WB) + (size_t)m * 2048 * 2048 + (size_t)nb * 32 * KD);
    u32x4* dst = (u32x4*)((bf16_t*)(P.ws + WS_WF) + (size_t)m * 2048 * 2048);
    u32x4 v[16];
#pragma unroll
    for (int i = 0; i < 16; ++i) v[i] = src[tid + 512 * i];
#pragma unroll
    for (int i = 0; i < 16; ++i) { const int p = tid + 512 * i, n = p >> 8, kg = p & 255; *(LAS u32x4*)(lds + (kg * 33 + n) * 16) = v[i]; }
    __syncthreads();
#pragma unroll
    for (int i = 0; i < 16; ++i) { const int p = tid + 512 * i, kg = p >> 5, n = p & 31; dst[(size_t)kg * 2048 + nb * 32 + n] = *(const LAS u32x4*)(lds + (kg * 33 + n) * 16); }
    __syncthreads();
}
constexpr int B_VN = 0, B_VNS = 528, B_WS = 67584, B_WSS = 272;
__device__ __forceinline__ void gmlp_item(const Params& P, LAS unsigned char* lds, unsigned ldsaddr, int rowbase, int nv, int grp, int sb) {
    int tid_ = threadIdx.x; asm volatile("" : "+v"(tid_));
    const int tid = tid_, lane = tid & 63, wave = __builtin_amdgcn_readfirstlane(tid >> 6), fr = lane & 15, fq = lane >> 4;
    const bf16_t* proj = (const bf16_t*)(P.ws + WS_PROJ); const float* LNS = (const float*)(P.ws + WS_LNS); bf16_t* ymlp = (bf16_t*)(P.ws + WS_YMLP);
    {
        const float* wsp = P.in[18] + (size_t)grp * 128 * 128;
#pragma unroll
        for (int k = 0; k < 8; ++k) { const int q = tid + 512 * k, i = q >> 5, j4 = (q & 31) * 4;
            const f32x4 v = *(const f32x4*)(wsp + i * 128 + j4);
            u32x2 o; o.x = pk2(j4 <= i ? v.x : 0.f, j4 + 1 <= i ? v.y : 0.f); o.y = pk2(j4 + 2 <= i ? v.z : 0.f, j4 + 3 <= i ? v.w : 0.f);
            *(LAS u32x2*)(lds + B_WS + i * B_WSS + j4 * 2) = o; }
    }
    {
#pragma unroll
        for (int k = 0; k < 8; ++k) { const int q = tid + 512 * k, j = q >> 5, c8 = (q & 31) * 8;
            u32x4 o = (u32x4){0u, 0u, 0u, 0u};
            if (j < nv) {
                const int row = rowbase + j, ch = grp * 256 + c8;
                const u32x4 raw = *(const u32x4*)(proj + pj(row, C_V + ch));
                const float mean = LNS[row * 2], rstd = LNS[row * 2 + 1];
                const f32x4 g0 = *(const f32x4*)(P.in[16] + ch), g1 = *(const f32x4*)(P.in[16] + ch + 4), b0 = *(const f32x4*)(P.in[17] + ch), b1 = *(const f32x4*)(P.in[17] + ch + 4);
                f32x4 v0 = (f32x4){bflo(raw.x), bfhi(raw.x), bflo(raw.y), bfhi(raw.y)}, v1 = (f32x4){bflo(raw.z), bfhi(raw.z), bflo(raw.w), bfhi(raw.w)};
                v0 = (v0 - mean) * rstd * g0 + b0; v1 = (v1 - mean) * rstd * g1 + b1;
                o.x = pk2(v0.x, v0.y); o.y = pk2(v0.z, v0.w); o.z = pk2(v1.x, v1.y); o.w = pk2(v1.z, v1.w);
                if (sb >= 0) { float* vo = P.out + O_VS + ((size_t)sb * 32 + j) * 2048 + ch; *(f32x4*)vo = v0; *(f32x4*)(vo + 4) = v1; }
            }
            *(LAS u32x4*)(lds + B_VN + j * B_VNS + c8 * 2) = o; }
    }
    __syncthreads();
    const int pr = wave & 3, hf = wave >> 2, itA = pr, itB = 7 - pr;
    u32x4 upre[2][4], zpre[2][4];
#pragma unroll
    for (int t = 0; t < 2; ++t) { const int it = t ? itB : itA, i = it * 16 + fr, row = rowbase + (i < nv ? i : 0);
#pragma unroll
        for (int cp = 0; cp < 4; ++cp) { const int cc = grp * 256 + (hf * 8 + 2 * cp + (fq & 1)) * 16 + (fq >> 1) * 8;
            upre[t][cp] = *(const u32x4*)(proj + pjf(row, C_U + cc)); zpre[t][cp] = *(const u32x4*)(proj + pjf(row, C_ZM + cc)); } }
    f32x4 acc[2][8];
#pragma unroll
    for (int t = 0; t < 2; ++t)
#pragma unroll
        for (int ct = 0; ct < 8; ++ct) acc[t][ct] = (f32x4){0.f, 0.f, 0.f, 0.f};
#pragma unroll
    for (int ks = 0; ks < 4; ++ks) {
        if (ks * 32 >= nv) break;
        const bool vA = ks * 32 <= itA * 16 + 15, vB = ks * 32 <= itB * 16 + 15;
        if (!vA && !vB) continue;
        const bf16x8 wA = rowfrag(lds + B_WS, itA * 16, B_WSS, ks * 32, fr, fq), wB = rowfrag(lds + B_WS, itB * 16, B_WSS, ks * 32, fr, fq);
        bf16x8 xv[8];
        tr8_vn(ldsaddr + B_VN + ks * 32 * B_VNS + hf * 8 * 32, lane, xv);
#pragma unroll
        for (int ct = 0; ct < 8; ++ct) {
            if (vA) acc[0][ct] = mma16(xv[ct], wA, acc[0][ct]);
            if (vB) acc[1][ct] = mma16(xv[ct], wB, acc[1][ct]); }
    }
#pragma unroll
    for (int t = 0; t < 2; ++t) { const int it = t ? itB : itA, i = it * 16 + fr;
        if (i < nv) { const int row = rowbase + i; const float bs = P.in[19][grp * 128 + i]; u32x2 go[8], uq[8], zq[8];
#pragma unroll
            for (int cp = 0; cp < 4; ++cp) { unwiden16(upre[t][cp], uq[2 * cp], uq[2 * cp + 1]); unwiden16(zpre[t][cp], zq[2 * cp], zq[2 * cp + 1]); }
#pragma unroll
            for (int ct = 0; ct < 8; ++ct) {
                const u32x2 uu = uq[ct], zz = zq[ct];
                const f32x4 a = acc[t][ct];
                const float y0 = bflo(uu.x) * (a[0] + bs) * silu_f(bflo(zz.x)), y1 = bfhi(uu.x) * (a[1] + bs) * silu_f(bfhi(zz.x));
                const float y2 = bflo(uu.y) * (a[2] + bs) * silu_f(bflo(zz.y)), y3 = bfhi(uu.y) * (a[3] + bs) * silu_f(bfhi(zz.y));
                go[ct].x = pk2(y0, y1); go[ct].y = pk2(y2, y3); }
#pragma unroll
            for (int cp = 0; cp < 4; ++cp) { const u32x4 w = widen16(go[2 * cp], go[2 * cp + 1]); const int ccw = grp * 256 + (hf * 8 + 2 * cp + (fq & 1)) * 16 + (fq >> 1) * 8;
                *(u32x4*)(ymlp + (size_t)row * DM + ccw) = w;
                if (sb >= 0) *(u32x4*)((bf16_t*)(P.ws + WS_AS) + (size_t)256 * 256 * 8 + pjs(row - TP, ccw)) = w; } } }
    __syncthreads();
}
__device__ __forceinline__ void phase4(const Params& P, LAS unsigned char* lds, unsigned ldsaddr) {
#if DUPK == 41
    for (int it = blockIdx.x; it < 256; it += gridDim.x) scan_prompt_item<true>(P, it);
#endif
#if DUPK == 40
    for (int it = blockIdx.x; it < 576; it += gridDim.x) {
        if (it < 512) { const int grp = it & 7, cc = (it >> 3) & 31, s = it >> 8; gmlp_item(P, lds, ldsaddr, s * 4096 + cc * 128, 128, grp, -1); }
        else { const int q = it - 512, grp = q & 7, sb = q >> 3; gmlp_item(P, lds, ldsaddr, TP + sb * 32, 32, grp, sb); }
    }
#endif
    for (int it = blockIdx.x; it < 1088; it += gridDim.x) {
        if (it < 512) { const int grp = it & 7, cc = (it >> 3) & 31, s = it >> 8; gmlp_item(P, lds, ldsaddr, s * 4096 + cc * 128, 128, grp, -1); }
        else if (it < 576) { const int q = it - 512, grp = q & 7, sb = q >> 3; gmlp_item(P, lds, ldsaddr, TP + sb * 32, 32, grp, sb); }
        else if (it < 832) scan_prompt_item<false>(P, it - 576);
        else scan_sample_item(P, it - 832);
    }
}

__device__ __forceinline__ void yoff_item(const Params& P, LAS unsigned char* lds, int ck, int g) {
    const int tid = threadIdx.x, lane = tid & 63, wave = __builtin_amdgcn_readfirstlane(tid >> 6), fr = lane & 15, fq = lane >> 4;
    const bool samp = ck >= 128;
    int row0, nv, sb = 0;
    if (!samp) { row0 = (ck >> 6) * 4096 + (ck & 63) * 64; nv = 64; } else { sb = ck - 128; row0 = TP + sb * 32; nv = 32; }
    const int hh = wave, h = g * 8 + hh;
    const bf16_t* proj = (const bf16_t*)(P.ws + WS_PROJ); bf16_t* YZ = (bf16_t*)(P.ws + WS_YZ); const bf16_t* S = (const bf16_t*)(P.ws + WS_S); const bf16_t* CPOST = (const bf16_t*)(P.ws + WS_CPOST);
    const bf16_t* YP = (const bf16_t*)(P.ws + WS_YP); const float* EAC = (const float*)(P.ws + WS_EAC); float* SSQ = (float*)(P.ws + WS_SSQ);
    bf16x8 hp[4][4];
    if (!samp) {
        const bf16_t* sp = S + (size_t)(ck * 32 + h) * 8192;
#pragma unroll
        for (int pt = 0; pt < 4; ++pt)
#pragma unroll
            for (int ks = 0; ks < 4; ++ks) hp[pt][ks] = *(const bf16x8*)(sp + ((ks * 4 + fq) * 64 + pt * 16 + fr) * 8);
    } else {
        const float* sp = P.in[2] + (size_t)(sb * 32 + h) * 8192;
#pragma unroll
        for (int pt = 0; pt < 4; ++pt)
#pragma unroll
            for (int ks = 0; ks < 4; ++ks) { const f32x4 a = *(const f32x4*)(sp + (pt * 16 + fr) * 128 + ks * 32 + fq * 8), b = *(const f32x4*)(sp + (pt * 16 + fr) * 128 + ks * 32 + fq * 8 + 4);
                u32x4 r; r.x = pk2(a.x, a.y); r.y = pk2(a.z, a.w); r.z = pk2(b.x, b.y); r.w = pk2(b.z, b.w); hp[pt][ks] = __builtin_bit_cast(bf16x8, r); }
    }
    LAS float* red = (LAS float*)lds;
    const int nit = nv >> 4;
    { const u32x4* csrc = (const u32x4*)(CPOST + (size_t)(ck * 4 + g) * 8192);
      const u32x4 c0 = csrc[tid], c1 = csrc[tid + 512];
      *(LAS u32x4*)(lds + 4096 + tid * 16) = c0; *(LAS u32x4*)(lds + 4096 + (tid + 512) * 16) = c1; }
    __syncthreads();
    bf16x8 cf[4][4];
#pragma unroll
    for (int it = 0; it < 4; ++it) { const int il = (it < nit ? it * 16 + fr : fr);
#pragma unroll
        for (int ks = 0; ks < 4; ++ks) cf[it][ks] = *(const LAS bf16x8*)(lds + 4096 + (((ks * 4 + fq) * 64 + il) * 8) * 2); }
    u32x4 ypre[2][2], zpre[2][2]; float eapre[2];
    { const int row = row0 + fr; eapre[0] = EAC[(size_t)row * 32 + h];
#pragma unroll
        for (int pt = 0; pt < 4; ++pt) { const int col = h * 64 + pt * 16 + fq * 4; if (!(pt & 1)) ypre[0][pt >> 1] = *(const u32x4*)(YP + (size_t)(ck * 32 + h) * 4096 + (((pt >> 1) * 4 + fq) * 64 + fr) * 8); if (!(pt & 1)) zpre[0][pt >> 1] = *(const u32x4*)(proj + pjf(row, C_ZS + h * 64 + (pt + (fq & 1)) * 16 + (fq >> 1) * 8)); } }
#pragma unroll
    for (int it = 0; it < 4; ++it) {
        if (it >= nit) break;
        const int i = it * 16 + fr, row = row0 + i;
        if (it + 1 < 4 && it + 1 < nit) { const int rn = row + 16; eapre[(it + 1) & 1] = EAC[(size_t)rn * 32 + h];
#pragma unroll
            for (int pt = 0; pt < 4; ++pt) { const int col = h * 64 + pt * 16 + fq * 4; if (!(pt & 1)) ypre[(it + 1) & 1][pt >> 1] = *(const u32x4*)(YP + (size_t)(ck * 32 + h) * 4096 + (((pt >> 1) * 4 + fq) * 64 + (it + 1) * 16 + fr) * 8); if (!(pt & 1)) zpre[(it + 1) & 1][pt >> 1] = *(const u32x4*)(proj + pjf(rn, C_ZS + h * 64 + (pt + (fq & 1)) * 16 + (fq >> 1) * 8)); } }
        f32x4 acc[4];
#pragma unroll
        for (int pt = 0; pt < 4; ++pt) acc[pt] = (f32x4){0.f, 0.f, 0.f, 0.f};
#pragma unroll
        for (int ks = 0; ks < 4; ++ks)
#pragma unroll
            for (int pt = 0; pt < 4; ++pt) acc[pt] = mma16(hp[pt][ks], cf[it][ks], acc[pt]);
        const float ea = eapre[it & 1]; float ssq = 0.f; u32x2 yo[4], zq[4];
        unwiden16(zpre[it & 1][0], zq[0], zq[1]); unwiden16(zpre[it & 1][1], zq[2], zq[3]);
#pragma unroll
        for (int pt = 0; pt < 4; ++pt) { const int col = h * 64 + pt * 16 + fq * 4;
            const u32x4 yq = ypre[it & 1][pt >> 1]; u32x2 yp; yp.x = (pt & 1) ? yq.z : yq.x; yp.y = (pt & 1) ? yq.w : yq.y; const u32x2 zz = zq[pt];
            const float y0 = (bflo(yp.x) + ea * acc[pt][0]) * silu_f(bflo(zz.x)), y1 = (bfhi(yp.x) + ea * acc[pt][1]) * silu_f(bfhi(zz.x));
            const float y2 = (bflo(yp.y) + ea * acc[pt][2]) * silu_f(bflo(zz.y)), y3 = (bfhi(yp.y) + ea * acc[pt][3]) * silu_f(bfhi(zz.y));
            ssq += (y0 * y0 + y1 * y1) + (y2 * y2 + y3 * y3);
            yo[pt].x = pk2(y0, y1); yo[pt].y = pk2(y2, y3); }
#pragma unroll
        for (int pp = 0; pp < 2; ++pp) { const u32x4 w = widen16(yo[2 * pp], yo[2 * pp + 1]); const int colw = h * 64 + (2 * pp + (fq & 1)) * 16 + (fq >> 1) * 8;
            *(u32x4*)(YZ + (size_t)row * DM + colw) = w;
            if (samp) *(u32x4*)((bf16_t*)(P.ws + WS_AS) + pjs(row - TP, colw)) = w; }
        ssq += __shfl_xor(ssq, 16); ssq += __shfl_xor(ssq, 32);
        if (fq == 0) red[hh * 64 + i] = ssq;
    }
    __syncthreads();
    if (tid < nv) { float v = 0.f;
#pragma unroll
        for (int q = 0; q < 8; ++q) v += red[q * 64 + tid];
        SSQ[(size_t)(row0 + tid) * 4 + g] = v; }
    __syncthreads();
}
__device__ __forceinline__ void phase5(const Params& P, LAS unsigned char* lds) {
    for (int it = blockIdx.x; it < 512; it += gridDim.x) yoff_item(P, lds, it >> 2, it & 3);
}
__device__ __forceinline__ void phase4b(const Params& P, LAS unsigned char* lds) {
    const int G = gridDim.x, first = G >= 64 ? G - 32 : 0, step = G >= 64 ? 32 : G;
    for (int e = (int)blockIdx.x - first; e < 32; e += step) if (e >= 0) yoff_item(P, lds, 128 + (e >> 2), e & 3);
}

struct SchedD {
    int G, c; const char* A0; const char* A1; const char* B0; const char* B1;
    __device__ __forceinline__ bool next(int i, Unit& u) const {
        const int L = (i >> 1) * G + c; if (L >= 256) return false;
        { const int xcd = L & 7, j = L >> 3; u.pm = xcd * 4 + (j & 3); u.pn = j >> 2; } u.w = i & 1; u.pad = 0;
        u.a = (u.w ? A1 : A0) + (size_t)u.pm * 256 * (DM * 2); u.b = (u.w ? B1 : B0) + (size_t)u.pn * 256 * (KD * 2); return true;
    }
};
struct EpiD {
    static constexpr bool PERM = true;
    const bf16_t* proj; bf16_t* mrg; const float* ssq;
    __device__ __forceinline__ bool operator()(f32x4 (&acc)[2][2][4][2], const Unit& u, int wr, int wc, int fr, int fq) const {
        const int row0 = u.pm * 256 + wr * 64 + fr, col0 = u.pn * 256 + wc * 32 + 8 * fq;
#pragma unroll
        for (int ai = 0; ai < 2; ++ai)
#pragma unroll
            for (int m = 0; m < 4; ++m) { const int row = row0 + ai * 128 + m * 16;
                float rs = 1.f;
                if (u.w == 0) { const f32x4 q = *(const f32x4*)(ssq + (size_t)row * 4); rs = rsqrtf(((q.x + q.y) + (q.z + q.w)) * (1.f / 2048.f) + EPS); }
#pragma unroll
                for (int bj = 0; bj < 2; ++bj) { const int col = col0 + bj * 128;
                    const u32x4 gm = *(const u32x4*)(proj + pjf(row, C_GM + col));
                    float eb[8] = {bflo(gm.x), bfhi(gm.x), bflo(gm.y), bfhi(gm.y), bflo(gm.z), bfhi(gm.z), bflo(gm.w), bfhi(gm.w)};
#pragma unroll
                    for (int e = 0; e < 8; ++e) eb[e] = 1.f + __expf(-fmaxf(eb[e], -30.f));
                    if (u.w == 0) {
                        const u32x4 gs = *(const u32x4*)(proj + pjf(row, C_GS + col));
                        float ea[8] = {bflo(gs.x), bfhi(gs.x), bflo(gs.y), bfhi(gs.y), bflo(gs.z), bfhi(gs.z), bflo(gs.w), bfhi(gs.w)};
#pragma unroll
                        for (int e = 0; e < 8; ++e) ea[e] = rs * eb[e] * __builtin_amdgcn_rcpf(1.f + __expf(-ea[e]));
                        acc[ai][bj][m][0] *= (f32x4){ea[0], ea[1], ea[2], ea[3]}; acc[ai][bj][m][1] *= (f32x4){ea[4], ea[5], ea[6], ea[7]};
                    } else {
#pragma unroll
                        for (int e = 0; e < 8; ++e) eb[e] = __builtin_amdgcn_rcpf(eb[e]);
                        const f32x4 v0 = acc[ai][bj][m][0] * (f32x4){eb[0], eb[1], eb[2], eb[3]}, v1 = acc[ai][bj][m][1] * (f32x4){eb[4], eb[5], eb[6], eb[7]};
                        u32x4 w; w.x = pk2(v0[0], v0[1]); w.y = pk2(v0[2], v0[3]); w.z = pk2(v1[0], v1[1]); w.w = pk2(v1[2], v1[3]);
                        *(u32x4*)(mrg + (size_t)row * DM + col) = w; } } }
        return u.w != 0;
    }
};
struct SchedE {
    int G, c; const char* A; const char* B;
    __device__ __forceinline__ bool next(int i, Unit& u) const {
        const int L = i * G + c; if (L >= 256) return false;
        { const int xcd = L & 7, j = L >> 3; u.pm = xcd * 4 + (j & 3); u.pn = j >> 2; } u.w = 0; u.pad = 0;
        u.a = A + (size_t)u.pm * 256 * (DM * 2); u.b = B + (size_t)u.pn * 256 * (KD * 2); return true;
    }
};
__device__ __forceinline__ void panel_wait(unsigned* cnt, unsigned need) {
    xb_add(cnt, 1u);
    unsigned sp = 0u;
    while (xb_ld(cnt) < need) { __builtin_amdgcn_s_sleep(1); if (++sp > (1u << 22)) break; }
}
struct EpiE {
    static constexpr bool PERM = false;
    const float* xp; const float* xs; const float* mods; const float* gfin; float* out; float* rss; unsigned* cnt; LAS unsigned char* lds;
    __device__ __forceinline__ bool operator()(f32x4 (&acc)[2][2][4][2], const Unit& u, int wr, int wc, int fr, int fq) const {
        const int tid = threadIdx.x;
        LAS float* part = (LAS float*)(lds + 131072);
        LAS float* rst = (LAS float*)(lds + 131072 + 4096);
        const int row0 = u.pm * 256 + wr * 64 + fr, col0 = u.pn * 256 + wc * 32 + 4 * fq;
        const float* gt = mods + stream_of(u.pm * 256) * 6144 + 4096;
        f32x4 gv[2][2];
#pragma unroll
        for (int bj = 0; bj < 2; ++bj)
#pragma unroll
            for (int n = 0; n < 2; ++n) gv[bj][n] = *(const f32x4*)(gt + col0 + bj * 128 + n * 16);
#pragma unroll
        for (int ai = 0; ai < 2; ++ai)
#pragma unroll
            for (int m = 0; m < 4; ++m) { const int row = row0 + ai * 128 + m * 16;
                const float* xr = row < TP ? xp + (size_t)row * DM : xs + (size_t)(row - TP) * DM;
                float ss = 0.f;
#pragma unroll
                for (int bj = 0; bj < 2; ++bj)
#pragma unroll
                    for (int n = 0; n < 2; ++n) { const int col = col0 + bj * 128 + n * 16;
                        const f32x4 o = *(const f32x4*)(xr + col) + gv[bj][n] * acc[ai][bj][m][n];
                        ss += (o.x * o.x + o.y * o.y) + (o.z * o.z + o.w * o.w);
                        acc[ai][bj][m][n] = o; }
                ss += __shfl_xor(ss, 16); ss += __shfl_xor(ss, 32);
                if (fq == 0) part[(ai * 128 + wr * 64 + m * 16 + fr) * 4 + wc] = ss; }
        __syncthreads();
        if (tid < 256) { const float v = (part[tid * 4] + part[tid * 4 + 1]) + (part[tid * 4 + 2] + part[tid * 4 + 3]);
            __hip_atomic_store(rss + (size_t)(u.pm * 256 + tid) * 32 + u.pn, v, __ATOMIC_RELAXED, __HIP_MEMORY_SCOPE_AGENT); }
        asm volatile("s_waitcnt vmcnt(0)" ::: "memory");
        __syncthreads();
        if (tid == 0) panel_wait(cnt + 64 * u.pm, 8u);
        __syncthreads();
        if (tid < 256) { float v = 0.f;
#pragma unroll
            for (int q = 0; q < 8; ++q) v += __hip_atomic_load(rss + (size_t)(u.pm * 256 + tid) * 32 + q, __ATOMIC_RELAXED, __HIP_MEMORY_SCOPE_AGENT);
            rst[tid] = rsqrtf(v * (1.f / DM) + EPS); }
        __syncthreads();
#pragma unroll
        for (int bj = 0; bj < 2; ++bj)
#pragma unroll
            for (int n = 0; n < 2; ++n) gv[bj][n] = *(const f32x4*)(gfin + col0 + bj * 128 + n * 16);
#pragma unroll
        for (int ai = 0; ai < 2; ++ai)
#pragma unroll
            for (int m = 0; m < 4; ++m) { const int rl = ai * 128 + wr * 64 + m * 16 + fr; const float r = rst[rl];
                float* op = out + (size_t)(u.pm * 256 + rl) * DM;
#pragma unroll
                for (int bj = 0; bj < 2; ++bj)
#pragma unroll
                    for (int n = 0; n < 2; ++n) { const int col = col0 + bj * 128 + n * 16; *(f32x4*)(op + col) = acc[ai][bj][m][n] * r * gv[bj][n]; } }
        return true;
    }
};
__device__ __forceinline__ f32x4 small_gemm(LAS unsigned char* lds, const bf16_t* As  , int rl0, const bf16_t* Wf  , int n0) {
    const int tid = threadIdx.x, lane = tid & 63, wave = __builtin_amdgcn_readfirstlane(tid >> 6), fr = lane & 15, fq = lane >> 4;
    f32x4 acc[2][4];
#pragma unroll
    for (int rt = 0; rt < 2; ++rt)
#pragma unroll
        for (int ct = 0; ct < 4; ++ct) acc[rt][ct] = (f32x4){0.f, 0.f, 0.f, 0.f};
    const bf16_t* ap = As + ((size_t)(wave * 32 + fq) * 256 + rl0 + fr) * 8; const bf16_t* bp = Wf + ((size_t)(wave * 32 + fq) * 2048 + n0 + fr) * 8;
    {
        bf16x8 af[2][8], bf[4][8];
#pragma unroll
        for (int ks = 0; ks < 8; ++ks) {
#pragma unroll
            for (int rt = 0; rt < 2; ++rt) af[rt][ks] = *(const bf16x8*)(ap + (size_t)ks * 4 * 256 * 8 + rt * 16 * 8);
#pragma unroll
            for (int ct = 0; ct < 4; ++ct) bf[ct][ks] = *(const bf16x8*)(bp + (size_t)ks * 4 * 2048 * 8 + ct * 16 * 8);
        }
        __builtin_amdgcn_sched_barrier(0);
#pragma unroll
        for (int ks = 0; ks < 8; ++ks)
#pragma unroll
            for (int rt = 0; rt < 2; ++rt)
#pragma unroll
                for (int ct = 0; ct < 4; ++ct) acc[rt][ct] = mma16(bf[ct][ks], af[rt][ks], acc[rt][ct]);
    }
#pragma unroll
    for (int rt = 0; rt < 2; ++rt)
#pragma unroll
        for (int ct = 0; ct < 4; ++ct) *(LAS f32x4*)(lds + ((wave * 8 + rt * 4 + ct) * 64 + lane) * 16) = acc[rt][ct];
    __syncthreads();
    f32x4 v = (f32x4){0.f, 0.f, 0.f, 0.f};
#pragma unroll
    for (int w = 0; w < 8; ++w) v += *(const LAS f32x4*)(lds + ((w * 8 + (tid >> 6)) * 64 + lane) * 16);
    __syncthreads();
    return v;
}
__device__ __forceinline__ void sample_merge(const Params& P, LAS unsigned char* lds) {
    const int tid = threadIdx.x, l = tid & 63, tile = tid >> 6, rt = tile >> 2, ct = tile & 3;
    const bf16_t* proj = (const bf16_t*)(P.ws + WS_PROJ);
    const bf16_t* AS = (const bf16_t*)(P.ws + WS_AS); const bf16_t* WF = (const bf16_t*)(P.ws + WS_WF); bf16_t* mrgs = (bf16_t*)(P.ws + WS_AS) + (size_t)2 * 256 * 256 * 8;
    const float* ssq = (const float*)(P.ws + WS_SSQ);
    for (int b = blockIdx.x; b < 256; b += gridDim.x) {
        const int r0 = TP + (b >> 5) * 32, n0 = (b & 31) * 64;
        const f32x4 v1 = small_gemm(lds, AS, r0 - TP, WF, n0);
        const f32x4 v2 = small_gemm(lds, AS + (size_t)256 * 256 * 8, r0 - TP, WF + (size_t)2048 * 2048, n0);
        const int row = r0 + rt * 16 + (l & 15), col = n0 + ct * 16 + (l >> 4) * 4;
        const f32x4 q = *(const f32x4*)(ssq + (size_t)row * 4); const float rs = rsqrtf(((q.x + q.y) + (q.z + q.w)) * (1.f / 2048.f) + EPS);
        const u32x2 gs = *(const u32x2*)(proj + pjf(row, C_GS + col)), gm = *(const u32x2*)(proj + pjf(row, C_GM + col));
        const float m0 = sigm_f(bflo(gs.x)) * rs * v1[0] + sigm_f(bflo(gm.x)) * v2[0], m1 = sigm_f(bfhi(gs.x)) * rs * v1[1] + sigm_f(bfhi(gm.x)) * v2[1];
        const float m2 = sigm_f(bflo(gs.y)) * rs * v1[2] + sigm_f(bflo(gm.y)) * v2[2], m3 = sigm_f(bfhi(gs.y)) * rs * v1[3] + sigm_f(bfhi(gm.y)) * v2[3];
        u32x2 o; o.x = pk2(m0, m1); o.y = pk2(m2, m3); *(u32x2*)(mrgs + pjs(row - TP, col)) = o;
    }
}
__device__ __forceinline__ void sample_out(const Params& P, LAS unsigned char* lds) {
    const int tid = threadIdx.x, l = tid & 63, tile = tid >> 6, rt = tile >> 2, ct = tile & 3;
    const bf16_t* Wof = (const bf16_t*)(P.ws + WS_WF) + (size_t)2 * 2048 * 2048; const bf16_t* mrgs = (const bf16_t*)(P.ws + WS_AS) + (size_t)2 * 256 * 256 * 8;
    const float* mods = (const float*)(P.ws + WS_MODS); float* rss = (float*)(P.ws + WS_RSS); unsigned* cnt = (unsigned*)(P.ws + WS_CNT);
    LAS float* rsum = (LAS float*)(lds + 65536);
    LAS float* rst = (LAS float*)(lds + 65536 + 512);
    for (int b = blockIdx.x; b < 256; b += gridDim.x) {
        const int sb = b >> 5, cb = b & 31, r0 = TP + sb * 32, n0 = cb * 64;
        const f32x4 v = small_gemm(lds, mrgs, r0 - TP, Wof, n0);
        const int m = rt * 16 + (l & 15), row = r0 + m, col = n0 + ct * 16 + (l >> 4) * 4;
        const f32x4 o = *(const f32x4*)(P.in[1] + (size_t)(row - TP) * DM + col) + *(const f32x4*)(mods + (2 + sb) * 6144 + 4096 + col) * v;
        float ss = (o.x * o.x + o.y * o.y) + (o.z * o.z + o.w * o.w);
        ss += __shfl_xor(ss, 16); ss += __shfl_xor(ss, 32);
        if ((l >> 4) == 0) rsum[m * 4 + ct] = ss;
        __syncthreads();
        if (tid < 32) __hip_atomic_store(rss + (size_t)(r0 + tid) * 32 + cb, (rsum[tid * 4] + rsum[tid * 4 + 1]) + (rsum[tid * 4 + 2] + rsum[tid * 4 + 3]), __ATOMIC_RELAXED, __HIP_MEMORY_SCOPE_AGENT);
        asm volatile("s_waitcnt vmcnt(0)" ::: "memory");
        __syncthreads();
        if (tid == 0) panel_wait(cnt + 64 * (32 + sb), 32u * (unsigned)((b - blockIdx.x) / gridDim.x + 1));
        __syncthreads();
        if (tid < 32) { float t = 0.f;
            for (int q = 0; q < 32; ++q) t += __hip_atomic_load(rss + (size_t)(r0 + tid) * 32 + q, __ATOMIC_RELAXED, __HIP_MEMORY_SCOPE_AGENT);
            rst[tid] = rsqrtf(t * (1.f / DM) + EPS); }
        __syncthreads();
        *(f32x4*)(P.out + (size_t)row * DM + col) = o * rst[m] * *(const f32x4*)(P.in[23] + col);
        __syncthreads();
    }
}
__device__ __forceinline__ void phase8(const Params& P) {
    const int tid = threadIdx.x, lane = tid & 63, wave = tid >> 6;
    const int gw = blockIdx.x * 8 + wave, NGW = gridDim.x * 8;
    const float* rss = (const float*)(P.ws + WS_RSS);
    for (int r = gw; r < T; r += NGW) {
        float s = lane < 32 ? rss[(size_t)r * 32 + lane] : 0.f;
        s = wave_sum(s);
        const float rstd = rsqrtf(s * (1.f / DM) + EPS);
        f32x4* op = (f32x4*)(P.out + (size_t)r * DM);
#pragma unroll
        for (int j = 0; j < 8; ++j) { const f32x4 g = *(const f32x4*)(P.in[23] + (lane + 64 * j) * 4); op[lane + 64 * j] = op[lane + 64 * j] * rstd * g; }
    }
}

__global__ __launch_bounds__(512, 2) void mega(Params P) {
    extern __shared__ __attribute__((aligned(16))) unsigned char smem[];
    LAS unsigned char* lds = (LAS unsigned char*)smem;
    const unsigned ldsaddr = (unsigned)(uintptr_t)smem;
    cg::grid_group grid = cg::this_grid();
    const int lo = P.ph_lo, hi = P.ph_hi;
    if (hi > 1000) grid.sync();
    volatile LAS unsigned* xst = (volatile LAS unsigned*)(lds + LDS_BYTES - 16);
    if (threadIdx.x == 0) { xst[0] = 0u; xst[1] = 0u; }
    __syncthreads();
    const XcdBarrier xb = xcd_barrier_post((unsigned*)(P.ws + WS_BAR), xst);
#define SEAM(k) if (lo < (k) && (k) < hi) xcd_barrier(xb)
#define REP(k) for (int rep_ = 0; rep_ < ((k) == DUPK ? 2 : 1); ++rep_, (((k) == DUPK && rep_ == 1) ? xcd_barrier(xb) : (void)0))
    if (lo <= 0 && 0 < hi) REP(0) phase0(P, lds);
    if (lo <= 1 && 1 < hi) REP(1) phase1(P);
    SEAM(2);
    if (lo <= 2 && 2 < hi) REP(2) {
        SchedIn S; S.nM = 33; S.nN = 61; S.nwg = 33 * 61; S.G = gridDim.x; S.c = blockIdx.x; S.A = (const char*)(P.ws + WS_H); S.B = (const char*)(P.ws + WS_WIN);
        EpiIn E; E.proj = (bf16_t*)(P.ws + WS_PROJ); E.dt = (float*)(P.ws + WS_DT); E.dt_bias = P.in[12];
        pg8::gemm_phase(lds, KD, KD * 2, S, E);
#if DUPK == 21
        xcd_barrier(xb);
        pg8::gemm_phase<false>(lds, KD, KD * 2, S, E);
#endif
    }
    SEAM(3);
    if (lo <= 3 && 3 < hi) REP(3) phase3(P, lds, ldsaddr);
    SEAM(4);
    if (lo <= 4 && 4 < hi) { phase4(P, lds, ldsaddr); phase4b(P, lds); }
    SEAM(5);
#if DUPK == 50
    xcd_barrier(xb); xcd_barrier(xb); xcd_barrier(xb); xcd_barrier(xb);
#endif
    if (lo <= 5 && 5 < hi) REP(5) phase5(P, lds);
    SEAM(6);
    if (lo <= 6 && 6 < hi) REP(6) {
        SchedD S; S.G = gridDim.x; S.c = blockIdx.x; S.A0 = (const char*)(P.ws + WS_YZ); S.A1 = (const char*)(P.ws + WS_YMLP);
        S.B0 = (const char*)(P.ws + WS_WB); S.B1 = (const char*)(P.ws + WS_WB) + (size_t)2048 * 2048 * 2;
        EpiD E; E.proj = (const bf16_t*)(P.ws + WS_PROJ); E.mrg = (bf16_t*)(P.ws + WS_MRG); E.ssq = (const float*)(P.ws + WS_SSQ);
        pg8::gemm_phase(lds, KD, DM * 2, S, E);
        sample_merge(P, lds);
#if DUPK == 60
        sample_merge(P, lds);
#endif
    }
    SEAM(7);
    if (lo <= 7 && 7 < hi) REP(7) {
        SchedE S; S.G = gridDim.x; S.c = blockIdx.x; S.A = (const char*)(P.ws + WS_MRG); S.B = (const char*)(P.ws + WS_WB) + (size_t)2 * 2048 * 2048 * 2;
        EpiE E; E.xp = P.in[0]; E.xs = P.in[1]; E.mods = (const float*)(P.ws + WS_MODS); E.gfin = P.in[23]; E.out = P.out; E.rss = (float*)(P.ws + WS_RSS); E.cnt = (unsigned*)(P.ws + WS_CNT); E.lds = lds;
        pg8::gemm_phase(lds, KD, DM * 2, S, E);
        sample_out(P, lds);
    }
#undef SEAM
}

#ifndef N_LAUNCH_PER_PHASE
#define N_LAUNCH_PER_PHASE 0
#endif
extern "C" void kernel_launch(void* const* d_in, const int* in_sizes, int n_in, void* d_out, int out_size, void* d_ws, size_t ws_size, hipStream_t stream) {
    static int grid = 0;
    if (grid == 0) {
        if (n_in != 24 || ws_size < WS_END) { fprintf(stderr, "kernel_launch: unexpected n_in %d / ws_size %zu\n", n_in, ws_size); grid = -1; return; }
        int dev = 0, cus = 0, per_cu = 0;
        hipGetDevice(&dev); hipDeviceGetAttribute(&cus, hipDeviceAttributeMultiprocessorCount, dev);
        if (hipFuncSetAttribute((const void*)mega, hipFuncAttributeMaxDynamicSharedMemorySize, LDS_BYTES) != hipSuccess) { fprintf(stderr, "kernel_launch: hipFuncSetAttribute failed\n"); grid = -1; return; }
        if (hipOccupancyMaxActiveBlocksPerMultiprocessor(&per_cu, (const void*)mega, 512, LDS_BYTES) != hipSuccess || per_cu < 1) { fprintf(stderr, "kernel_launch: occupancy query gave %d\n", per_cu); per_cu = 1; }
        (void)hipGetLastError();
        grid = cus;
        fprintf(stderr, "kernel_launch: cus %d per_cu %d grid %d\n", cus, per_cu, grid);
    }
    if (grid < 0) return;
    if (hipMemsetAsync((char*)d_ws + WS_BAR, 0, 32768, stream) != hipSuccess) { fprintf(stderr, "kernel_launch: memset failed\n"); return; }
    Params p{};
    for (int i = 0; i < 24; ++i) p.in[i] = (const float*)d_in[i];
    p.out = (float*)d_out; p.ws = (unsigned char*)d_ws;
#if N_LAUNCH_PER_PHASE
    for (int ph = 0; ph < 8; ++ph) { p.ph_lo = ph; p.ph_hi = ph + 1; hipLaunchKernelGGL(mega, dim3(grid), dim3(512), LDS_BYTES, stream, p); }
#else
    p.ph_lo = 0; p.ph_hi = 8;
    void* args[] = {&p};
    hipError_t e = hipLaunchCooperativeKernel((const void*)mega, dim3(grid), dim3(512), args, LDS_BYTES, stream);
    if (e != hipSuccess) fprintf(stderr, "cooperative launch failed: %s (grid %d)\n", hipGetErrorString(e), grid);
#endif
}
```

```cpp
#include <hip/hip_runtime.h>
#include <hip/hip_cooperative_groups.h>
#include <cstdio>
#include <cstdint>
namespace cg = cooperative_groups;
#ifndef DUPK
#define DUPK -1
#endif

#define LAS __attribute__((address_space(3)))
typedef unsigned short bf16_t;
typedef short bf16x8 __attribute__((ext_vector_type(8)));
typedef float f32x4 __attribute__((ext_vector_type(4)));
typedef unsigned u32x4 __attribute__((ext_vector_type(4)));
typedef unsigned u32x2 __attribute__((ext_vector_type(2)));

constexpr int T = 8448, TP = 8192, DM = 2048, NPJ = 15360, NBT = 15616, KD = 2048;
constexpr int C_ZS = 0, C_XS = 2048, C_U = 5120, C_V = 7168, C_ZM = 9216, C_GS = 11264, C_GM = 13312;
constexpr float EPS = 1e-5f;
constexpr int LDS_BYTES = 139264;

constexpr size_t WS_WIN = 0;
constexpr size_t WS_H = 63963136;
constexpr size_t WS_S = 0;
constexpr size_t WS_PART = 0;
constexpr size_t WS_WB = 98566144;
constexpr size_t WS_PROJ = 123731968;
constexpr size_t WS_WF = 464821248;
constexpr size_t WS_AS = WS_WF + 3 * 8388608;
constexpr size_t WS_DT = 383254528;
constexpr size_t WS_EAC = 384335872;
constexpr size_t WS_YP = 385417216;
constexpr size_t WS_CPOST = 71303168;
constexpr size_t WS_MODS = 428670976;
constexpr size_t WS_BDEC = 428916736;
constexpr size_t WS_LNS = 428934144;
constexpr size_t WS_SSQ = 429001728;
constexpr size_t WS_RSS = 429136896;
constexpr size_t WS_YZ = 430218240;
constexpr size_t WS_YMLP = WS_PROJ + 34603008;
constexpr size_t WS_MRG = WS_YP;
constexpr size_t WS_BAR = 499424256;
constexpr size_t WS_CNT = WS_BAR + 16384;
constexpr size_t WS_END = 499424256 + 32768;

constexpr size_t O_Y = 0, O_SSMP = 17301504, O_CONVP = 17825792, O_SSMS = 17844224, O_CONVS = 19941376, O_VS = 20015104;

struct Params { const float* in[24]; float* out; unsigned char* ws; int ph_lo, ph_hi; };

typedef __bf16 bf16x2_t __attribute__((ext_vector_type(2)));
__device__ __forceinline__ unsigned pk2(float lo, float hi) { bf16x2_t v; v.x = (__bf16)lo; v.y = (__bf16)hi; return __builtin_bit_cast(unsigned, v); }
__device__ __forceinline__ float bflo(unsigned u) { return __uint_as_float(u << 16); }
__device__ __forceinline__ float bfhi(unsigned u) { return __uint_as_float(u & 0xffff0000u); }
__device__ __forceinline__ float silu_f(float x) { return x * __builtin_amdgcn_rcpf(1.f + __expf(-x)); }
__device__ __forceinline__ float sigm_f(float x) { return __builtin_amdgcn_rcpf(1.f + __expf(-x)); }
__device__ __forceinline__ float wave_sum(float v) {
#pragma unroll
    for (int o = 1; o < 64; o <<= 1) v += __shfl_xor(v, o);
    return v;
}
__device__ __forceinline__ f32x4 mma16(bf16x8 a, bf16x8 b, f32x4 c) { return __builtin_amdgcn_mfma_f32_16x16x32_bf16(a, b, c, 0, 0, 0); }
__device__ __forceinline__ bf16x8 rowfrag(const LAS unsigned char* base, int r0, int stride, int k0, int fr, int fq) {
    return *(const LAS bf16x8*)(base + (r0 + fr) * stride + (k0 + fq * 8) * 2);
}
__device__ __forceinline__ bf16x8 trfrag(unsigned base_addr, int k0, int n0, int stride, int lane) {
    const int g = lane >> 4, q = (lane & 15) >> 2, p = lane & 3;
    const unsigned a0 = base_addr + (unsigned)((k0 + 8 * g + q) * stride + (n0 + 4 * p) * 2);
    const unsigned a1 = a0 + 4u * (unsigned)stride;
    u32x2 r0, r1;
    asm volatile("ds_read_b64_tr_b16 %0, %2\n\tds_read_b64_tr_b16 %1, %3\n\ts_waitcnt lgkmcnt(0)" : "=&v"(r0), "=&v"(r1) : "v"(a0), "v"(a1) : "memory");
    u32x4 r; r.x = r0.x; r.y = r0.y; r.z = r1.x; r.w = r1.y;
    return __builtin_bit_cast(bf16x8, r);
}
__device__ __forceinline__ void tr8_xc(unsigned base_addr, int lane, bf16x8 (&out)[4][2]) {
    const int g = lane >> 4, q = (lane & 15) >> 2, p = lane & 3;
    const unsigned a0 = base_addr + (unsigned)((8 * g + q) * 1040 + 8 * p);
    u32x2 r[16];
    asm volatile("ds_read_b64_tr_b16 %0, %8 offset:0\n\t"
        "ds_read_b64_tr_b16 %1, %8 offset:4160\n\t"
        "ds_read_b64_tr_b16 %2, %8 offset:33280\n\t"
        "ds_read_b64_tr_b16 %3, %8 offset:37440\n\t"
        "ds_read_b64_tr_b16 %4, %8 offset:32\n\t"
        "ds_read_b64_tr_b16 %5, %8 offset:4192\n\t"
        "ds_read_b64_tr_b16 %6, %8 offset:33312\n\t"
        "ds_read_b64_tr_b16 %7, %8 offset:37472\n\t"
        "s_waitcnt lgkmcnt(0)" : "=&v"(r[0]), "=&v"(r[1]), "=&v"(r[2]), "=&v"(r[3]), "=&v"(r[4]), "=&v"(r[5]), "=&v"(r[6]), "=&v"(r[7]) : "v"(a0) : "memory");
    asm volatile("ds_read_b64_tr_b16 %0, %8 offset:64\n\t"
        "ds_read_b64_tr_b16 %1, %8 offset:4224\n\t"
        "ds_read_b64_tr_b16 %2, %8 offset:33344\n\t"
        "ds_read_b64_tr_b16 %3, %8 offset:37504\n\t"
        "ds_read_b64_tr_b16 %4, %8 offset:96\n\t"
        "ds_read_b64_tr_b16 %5, %8 offset:4256\n\t"
        "ds_read_b64_tr_b16 %6, %8 offset:33376\n\t"
        "ds_read_b64_tr_b16 %7, %8 offset:37536\n\t"
        "s_waitcnt lgkmcnt(0)" : "=&v"(r[8]), "=&v"(r[9]), "=&v"(r[10]), "=&v"(r[11]), "=&v"(r[12]), "=&v"(r[13]), "=&v"(r[14]), "=&v"(r[15]) : "v"(a0) : "memory");
#pragma unroll
    for (int a = 0; a < 4; ++a)
#pragma unroll
        for (int ks = 0; ks < 2; ++ks) { u32x4 v; v.x = r[(a * 2 + ks) * 2].x; v.y = r[(a * 2 + ks) * 2].y; v.z = r[(a * 2 + ks) * 2 + 1].x; v.w = r[(a * 2 + ks) * 2 + 1].y; out[a][ks] = __builtin_bit_cast(bf16x8, v); }
}
__device__ __forceinline__ void tr8_bm(unsigned base_addr, int lane, bf16x8 (&out)[4][2]) {
    const int g = lane >> 4, q = (lane & 15) >> 2, p = lane & 3;
    const unsigned a0 = base_addr + (unsigned)((8 * g + q) * 272 + 8 * p);
    u32x2 r[16];
    asm volatile("ds_read_b64_tr_b16 %0, %8 offset:0\n\t"
        "ds_read_b64_tr_b16 %1, %8 offset:1088\n\t"
        "ds_read_b64_tr_b16 %2, %8 offset:8704\n\t"
        "ds_read_b64_tr_b16 %3, %8 offset:9792\n\t"
        "ds_read_b64_tr_b16 %4, %8 offset:32\n\t"
        "ds_read_b64_tr_b16 %5, %8 offset:1120\n\t"
        "ds_read_b64_tr_b16 %6, %8 offset:8736\n\t"
        "ds_read_b64_tr_b16 %7, %8 offset:9824\n\t"
        "s_waitcnt lgkmcnt(0)" : "=&v"(r[0]), "=&v"(r[1]), "=&v"(r[2]), "=&v"(r[3]), "=&v"(r[4]), "=&v"(r[5]), "=&v"(r[6]), "=&v"(r[7]) : "v"(a0) : "memory");
    asm volatile("ds_read_b64_tr_b16 %0, %8 offset:64\n\t"
        "ds_read_b64_tr_b16 %1, %8 offset:1152\n\t"
        "ds_read_b64_tr_b16 %2, %8 offset:8768\n\t"
        "ds_read_b64_tr_b16 %3, %8 offset:9856\n\t"
        "ds_read_b64_tr_b16 %4, %8 offset:96\n\t"
        "ds_read_b64_tr_b16 %5, %8 offset:1184\n\t"
        "ds_read_b64_tr_b16 %6, %8 offset:8800\n\t"
        "ds_read_b64_tr_b16 %7, %8 offset:9888\n\t"
        "s_waitcnt lgkmcnt(0)" : "=&v"(r[8]), "=&v"(r[9]), "=&v"(r[10]), "=&v"(r[11]), "=&v"(r[12]), "=&v"(r[13]), "=&v"(r[14]), "=&v"(r[15]) : "v"(a0) : "memory");
#pragma unroll
    for (int a = 0; a < 4; ++a)
#pragma unroll
        for (int ks = 0; ks < 2; ++ks) { u32x4 v; v.x = r[(a * 2 + ks) * 2].x; v.y = r[(a * 2 + ks) * 2].y; v.z = r[(a * 2 + ks) * 2 + 1].x; v.w = r[(a * 2 + ks) * 2 + 1].y; out[a][ks] = __builtin_bit_cast(bf16x8, v); }
}
__device__ __forceinline__ void tr8_vn(unsigned base_addr, int lane, bf16x8 (&out)[8]) {
    const int g = lane >> 4, q = (lane & 15) >> 2, p = lane & 3;
    const unsigned a0 = base_addr + (unsigned)((8 * g + q) * 528 + 8 * p);
    u32x2 r[16];
    asm volatile("ds_read_b64_tr_b16 %0, %16 offset:0\n\t"
        "ds_read_b64_tr_b16 %1, %16 offset:2112\n\t"
        "ds_read_b64_tr_b16 %2, %16 offset:32\n\t"
        "ds_read_b64_tr_b16 %3, %16 offset:2144\n\t"
        "ds_read_b64_tr_b16 %4, %16 offset:64\n\t"
        "ds_read_b64_tr_b16 %5, %16 offset:2176\n\t"
        "ds_read_b64_tr_b16 %6, %16 offset:96\n\t"
        "ds_read_b64_tr_b16 %7, %16 offset:2208\n\t"
        "ds_read_b64_tr_b16 %8, %16 offset:128\n\t"
        "ds_read_b64_tr_b16 %9, %16 offset:2240\n\t"
        "ds_read_b64_tr_b16 %10, %16 offset:160\n\t"
        "ds_read_b64_tr_b16 %11, %16 offset:2272\n\t"
        "ds_read_b64_tr_b16 %12, %16 offset:192\n\t"
        "ds_read_b64_tr_b16 %13, %16 offset:2304\n\t"
        "ds_read_b64_tr_b16 %14, %16 offset:224\n\t"
        "ds_read_b64_tr_b16 %15, %16 offset:2336\n\t"
        "s_waitcnt lgkmcnt(0)" : "=&v"(r[0]), "=&v"(r[1]), "=&v"(r[2]), "=&v"(r[3]), "=&v"(r[4]), "=&v"(r[5]), "=&v"(r[6]), "=&v"(r[7]), "=&v"(r[8]), "=&v"(r[9]), "=&v"(r[10]), "=&v"(r[11]), "=&v"(r[12]), "=&v"(r[13]), "=&v"(r[14]), "=&v"(r[15]) : "v"(a0) : "memory");
#pragma unroll
    for (int a = 0; a < 8; ++a) { u32x4 v; v.x = r[2 * a].x; v.y = r[2 * a].y; v.z = r[2 * a + 1].x; v.w = r[2 * a + 1].y; out[a] = __builtin_bit_cast(bf16x8, v); }
}
__device__ __forceinline__ u32x4 widen16(u32x2 A, u32x2 B) {
    const auto r0 = __builtin_amdgcn_permlane16_swap(A.x, B.x, false, false);
    const auto r1 = __builtin_amdgcn_permlane16_swap(A.y, B.y, false, false);
    u32x4 o; o.x = r0[0]; o.y = r1[0]; o.z = r0[1]; o.w = r1[1]; return o;
}
__device__ __forceinline__ void unwiden16(u32x4 w, u32x2& A, u32x2& B) {
    const auto r0 = __builtin_amdgcn_permlane16_swap(w.x, w.z, false, false);
    const auto r1 = __builtin_amdgcn_permlane16_swap(w.y, w.w, false, false);
    A.x = r0[0]; A.y = r1[0]; B.x = r0[1]; B.y = r1[1];
}
__device__ __forceinline__ bf16x8 pack8(const float* m) {
    u32x4 r; r.x = pk2(m[0], m[1]); r.y = pk2(m[2], m[3]); r.z = pk2(m[4], m[5]); r.w = pk2(m[6], m[7]);
    return __builtin_bit_cast(bf16x8, r);
}
__device__ __forceinline__ size_t pj(int row, int col) { return ((size_t)(col >> 8) * T + row) * 256 + (col & 255); }
__device__ __forceinline__ size_t pjf(int row, int col) { return ((size_t)(col >> 3) * T + row) * 8 + (col & 7); }
__device__ __forceinline__ bool pn_is_frag(int pn) { return !((pn >= 8 && pn < 20) || (pn >= 28 && pn < 36)); }
__device__ __forceinline__ size_t pjs(int rl, int col) { return ((size_t)(col >> 3) * 256 + rl) * 8 + (col & 7); }
__device__ __forceinline__ int stream_of(int r) { return r < TP ? (r >> 12) : 2 + ((r - TP) >> 5); }


#define XB_TMO      128
#define XB_XCNT(j)  (256  + 64 * (j))
#define XB_XSUB(j)  (1280 + 64 * (j))
#define XB_XGEN(j)  (2304 + 64 * (j))
#define XB_TOP      3328
#define XB_TOPGEN   3392
#define XCD_BAR_WORDS 3456
#define XB_SPIN_CAP (1u << 18)
__device__ __forceinline__ unsigned xb_ld(unsigned* p)              { return __hip_atomic_load(p, __ATOMIC_RELAXED, __HIP_MEMORY_SCOPE_AGENT); }
__device__ __forceinline__ unsigned xb_add(unsigned* p, unsigned v) { return __hip_atomic_fetch_add(p, v, __ATOMIC_RELAXED, __HIP_MEMORY_SCOPE_AGENT); }
__device__ __forceinline__ unsigned xb_xcc_id() { return (unsigned)__builtin_amdgcn_s_getreg((3 << 11) | 20) & 0xFu; }
#define XB_SPIN(cond, bar) do { unsigned _sp = 0; while (cond) { __builtin_amdgcn_s_sleep(1); \
    if ((++_sp & 255u) == 0u) { if (xb_ld(&(bar)[XB_TMO])) break; if (_sp > XB_SPIN_CAP) { atomicAdd(&(bar)[XB_TMO], 1u); break; } } } } while (0)
struct XcdBarrier { unsigned* bar; unsigned x; volatile LAS unsigned* st; };
__device__ __forceinline__ XcdBarrier xcd_barrier_post(unsigned* bar, volatile LAS unsigned* st) {
    XcdBarrier b; b.bar = bar; b.x = xb_xcc_id(); b.st = st;
    if (threadIdx.x == 0) (void)xb_add(&bar[XB_XCNT(b.x)], 1u);
    return b;
}
__device__ __forceinline__ void xcd_barrier_complete(unsigned* bar, unsigned x, unsigned& nloc, unsigned& nx) {
    const unsigned G = gridDim.x * gridDim.y * gridDim.z;
    unsigned sum, cnt, mine, sp = 0u;
    for (;;) {
        sum = 0u; cnt = 0u; mine = 0u;
#pragma unroll
        for (unsigned j = 0; j < 16; ++j) { const unsigned c = xb_ld(&bar[XB_XCNT(j)]); sum += c; cnt += (c > 0u) ? 1u : 0u; mine = (j == x) ? c : mine; }
        if (sum == G) break;
        __builtin_amdgcn_s_sleep(1);
        if ((++sp & 255u) == 0u) { if (xb_ld(&bar[XB_TMO])) break; if (sp > XB_SPIN_CAP) { atomicAdd(&bar[XB_TMO], 1u); break; } }
    }
    nloc = mine > 0u ? mine : 1u; nx = cnt > 0u ? cnt : 1u;
}
__device__ __forceinline__ void xcd_barrier(const XcdBarrier& b) {
    asm volatile("s_waitcnt vmcnt(0)" ::: "memory");
    __syncthreads();
    if (threadIdx.x == 0) {
        unsigned* bar = b.bar;
        __builtin_amdgcn_s_waitcnt(0);
        unsigned nloc = b.st[0], nx = b.st[1];
        if (nloc == 0u) { xcd_barrier_complete(bar, b.x, nloc, nx); b.st[0] = nloc; b.st[1] = nx; }
        const unsigned old = xb_add(&bar[XB_XSUB(b.x)], 1u);
        const unsigned gen = old / nloc;
        if (old + 1u == (gen + 1u) * nloc) {
            __builtin_amdgcn_fence(__ATOMIC_RELEASE, "agent");
            asm volatile("s_waitcnt vmcnt(0)" ::: "memory");
            const unsigned og = xb_add(&bar[XB_TOP], 1u);
            const unsigned tg = og / nx;
            if (og + 1u == (tg + 1u) * nx) xb_add(&bar[XB_TOPGEN], 1u);
            else XB_SPIN(xb_ld(&bar[XB_TOPGEN]) == tg, bar);
            __builtin_amdgcn_fence(__ATOMIC_ACQUIRE, "agent");
            xb_add(&bar[XB_XGEN(b.x)], 1u);
            asm volatile("s_waitcnt vmcnt(0)" ::: "memory");
        } else {
            XB_SPIN(xb_ld(&bar[XB_XGEN(b.x)]) == gen, bar);
            __builtin_amdgcn_fence(__ATOMIC_ACQUIRE, "agent");
            asm volatile("s_waitcnt vmcnt(0)" ::: "memory");
        }
    }
    __syncthreads();
}

namespace pg8 {
constexpr int BM = 256, BK = 64, HALF = 128, HTB = HALF * BK * 2, STAGE_BYTES = 8 * HTB, NXCD = 8, WGM = 8;
__host__ __device__ __forceinline__ int lds_byte(int r, int c) { const int st = (r >> 4) * 2 + (c >> 5), rr = r & 15, cc = c & 31, ob = rr * 64 + cc * 2; return st * 1024 + (ob ^ (((ob >> 9) & 1) << 5)); }
__host__ __device__ __forceinline__ void stage_rc(int b, int& R, int& C) { const int st = b / 1024, sb = b % 1024, swz = sb ^ (((sb >> 9) & 1) << 5); R = (st >> 1) * 16 + swz / 64; C = (st & 1) * 32 + (swz % 64) / 2; }
__host__ __device__ __forceinline__ int perm32(int rho) { const int n = rho >> 4, i = rho & 15; return 8 * (i >> 2) + 4 * n + (i & 3); }

struct Unit { int pm, pn, w, pad; const char* a; const char* b; };

template <bool DOEPI = true, class Epi, class Sched>
__device__ __forceinline__ void gemm_phase(LAS unsigned char* lds, const int K, const int lda  , const Sched& S, const Epi& E) {
    const int tid = threadIdx.x, wid = __builtin_amdgcn_readfirstlane(tid >> 6), lane = tid & 63, wr = wid >> 2, wc = wid & 3, fr = lane & 15, fq = lane >> 4;
    const int nt = K / BK;
    unsigned voffA[2], voffB[2];
#pragma unroll
    for (int i = 0; i < 2; ++i) { int R, C; stage_rc(tid * 16 + i * 8192, R, C); const int Rb = Epi::PERM ? ((R & ~31) + perm32(R & 31)) : R;
        voffA[i] = (unsigned)(R * lda + C * 2); voffB[i] = (unsigned)(Rb * K + C) * 2u; }
    const size_t kstep = (size_t)(BK * 2);
    const size_t hstepA = (size_t)HALF * lda, hstepB = (size_t)HALF * K * 2;
    const unsigned ldsw = (unsigned)wid * 1024u;
    const int aoff = lds_byte(wr * 64 + fr, fq * 8), boff = lds_byte(wc * 32 + fr, fq * 8);
#define PG8_SA(b, h) (((b) * 2 + (h)) * HTB)
#define PG8_SB(b, h) ((4 + (b) * 2 + (h)) * HTB)
#define PG8_STAGE(bufoff, gbase, voff) do { _Pragma("unroll") for (int _i = 0; _i < 2; ++_i) \
        __builtin_amdgcn_global_load_lds((const unsigned*)((const char*)(gbase) + (voff)[_i]), (LAS unsigned*)(lds + (bufoff) + ldsw + _i * 8192), 16, 0, 0); } while (0)
#define PG8_LDA(dst, b, h) do { _Pragma("unroll") for (int m = 0; m < 4; ++m) _Pragma("unroll") for (int k = 0; k < 2; ++k) dst[m][k] = *(const LAS bf16x8*)(lds + PG8_SA(b, h) + aoff + m * 2048 + k * 1024); } while (0)
#define PG8_LDB(dst, b, h) do { _Pragma("unroll") for (int n = 0; n < 2; ++n) _Pragma("unroll") for (int k = 0; k < 2; ++k) dst[n][k] = *(const LAS bf16x8*)(lds + PG8_SB(b, h) + boff + n * 2048 + k * 1024); } while (0)
#define PG8_MMA(ai, bj, At, Bt) do { __builtin_amdgcn_s_setprio(1); _Pragma("unroll") for (int m = 0; m < 4; ++m) _Pragma("unroll") for (int n = 0; n < 2; ++n) _Pragma("unroll") for (int k = 0; k < 2; ++k) \
        acc[ai][bj][m][n] = __builtin_amdgcn_mfma_f32_16x16x32_bf16(Bt[n][k], At[m][k], acc[ai][bj][m][n], 0, 0, 0); __builtin_amdgcn_s_setprio(0); } while (0)
#define PG8_WAIT_V(n) asm volatile("s_waitcnt vmcnt(" #n ")" ::: "memory")
#define PG8_WAIT_L(n) asm volatile("s_waitcnt lgkmcnt(" #n ")" ::: "memory")
#define PG8_BAR __builtin_amdgcn_s_barrier()
#define PG8_SCHED __builtin_amdgcn_sched_barrier(0)
    Unit cur, nxt; int ui = 0;
    if (!S.next(0, cur)) return;
    f32x4 acc[2][2][4][2];
#pragma unroll
    for (int a = 0; a < 2; ++a)
#pragma unroll
        for (int b = 0; b < 2; ++b)
#pragma unroll
            for (int m = 0; m < 4; ++m)
#pragma unroll
                for (int n = 0; n < 2; ++n) acc[a][b][m][n] = (f32x4){0.f, 0.f, 0.f, 0.f};
    bf16x8 At[4][2], B0[2][2], B1[2][2];
    const char* cA = cur.a; const char* cB = cur.b;
    PG8_STAGE(PG8_SB(0, 0), cB, voffB); PG8_STAGE(PG8_SB(0, 1), cB + hstepB, voffB); PG8_STAGE(PG8_SA(0, 0), cA, voffA); PG8_STAGE(PG8_SA(0, 1), cA + hstepA, voffA);
    if (wr == 1) PG8_BAR;
    PG8_WAIT_V(2); PG8_BAR;
    PG8_STAGE(PG8_SB(1, 0), cB + kstep, voffB); PG8_STAGE(PG8_SA(1, 0), cA + kstep, voffA); PG8_STAGE(PG8_SB(1, 1), cB + hstepB + kstep, voffB);
    PG8_WAIT_V(6); PG8_BAR;
    for (;;) {
        const bool has_next = S.next(ui + 1, nxt);
        const char* nA = has_next ? nxt.a : cA; const char* nB = has_next ? nxt.b : cB;
        for (int t = 0; t < nt; t += 2) {
            const bool last = (t == nt - 2);
            const char* a1 = cA + (size_t)(t + 1) * kstep;
            const char* a2 = last ? nA : cA + (size_t)(t + 2) * kstep; const char* b2 = last ? nB : cB + (size_t)(t + 2) * kstep;
            const char* a3 = a2 + kstep; const char* b3 = b2 + kstep;
            PG8_LDB(B0, 0, 0); PG8_LDB(B1, 0, 1); PG8_SCHED; PG8_LDA(At, 0, 0); PG8_STAGE(PG8_SA(1, 1), a1 + hstepA, voffA);
            PG8_WAIT_V(8); PG8_WAIT_L(0); PG8_BAR; PG8_MMA(0, 0, At, B0); PG8_MMA(0, 1, At, B1); PG8_BAR; PG8_SCHED;
            PG8_LDA(At, 0, 1); PG8_STAGE(PG8_SB(0, 0), b2, voffB); PG8_STAGE(PG8_SB(0, 1), b2 + hstepB, voffB); PG8_STAGE(PG8_SA(0, 0), a2, voffA);
            PG8_WAIT_V(8); PG8_WAIT_L(0); PG8_BAR; PG8_MMA(1, 0, At, B0); PG8_MMA(1, 1, At, B1); PG8_BAR; PG8_SCHED;
            PG8_LDB(B0, 1, 0); PG8_LDB(B1, 1, 1); PG8_SCHED; PG8_LDA(At, 1, 0); PG8_STAGE(PG8_SA(0, 1), a2 + hstepA, voffA);
            PG8_WAIT_V(8); PG8_WAIT_L(0); PG8_BAR; PG8_MMA(0, 0, At, B0); PG8_MMA(0, 1, At, B1); PG8_BAR; PG8_SCHED;
            PG8_LDA(At, 1, 1); PG8_STAGE(PG8_SB(1, 0), b3, voffB); PG8_STAGE(PG8_SB(1, 1), b3 + hstepB, voffB); PG8_STAGE(PG8_SA(1, 0), a3, voffA);
            PG8_WAIT_V(8); PG8_WAIT_L(0); PG8_BAR; PG8_MMA(1, 0, At, B0); PG8_MMA(1, 1, At, B1); PG8_BAR; PG8_SCHED;
        }
        if (wr == 0) PG8_BAR;
        bool zacc = true;
        if (DOEPI) zacc = E(acc, cur, wr, wc, fr, fq);
        else { f32x4 t = (f32x4){0.f, 0.f, 0.f, 0.f};
#pragma unroll
            for (int a = 0; a < 2; ++a)
#pragma unroll
                for (int b = 0; b < 2; ++b)
#pragma unroll
                    for (int m = 0; m < 4; ++m)
#pragma unroll
                        for (int n = 0; n < 2; ++n) t += acc[a][b][m][n];
            if (t.x + t.y + t.z + t.w == 123456.789f) *(volatile float*)cur.a = 0.f; }
        if (!has_next) break;
        if (zacc) {
#pragma unroll
        for (int a = 0; a < 2; ++a)
#pragma unroll
            for (int b = 0; b < 2; ++b)
#pragma unroll
                for (int m = 0; m < 4; ++m)
#pragma unroll
                    for (int n = 0; n < 2; ++n) acc[a][b][m][n] = (f32x4){0.f, 0.f, 0.f, 0.f};
        }
        cur = nxt; cA = nA; cB = nB; ++ui;
        if (wr == 1) PG8_BAR;
    }
    PG8_WAIT_V(0);
    PG8_BAR;
#undef PG8_SA
#undef PG8_SB
#undef PG8_STAGE
#undef PG8_LDA
#undef PG8_LDB
#undef PG8_MMA
#undef PG8_WAIT_V
#undef PG8_WAIT_L
#undef PG8_BAR
#undef PG8_SCHED
}
}
using pg8::Unit;

__device__ __forceinline__ void phase0(const Params& P, LAS unsigned char* lds) {
    const int tid = threadIdx.x, lane = tid & 63, wave = tid >> 6;
    float* mods = (float*)(P.ws + WS_MODS);
    if (blockIdx.x < 192) {
        LAS float* sc = (LAS float*)lds;
        LAS float* red = (LAS float*)(lds + 81920);
        for (int i = tid; i < 10 * 2048; i += 512) { const int s = i >> 11, k = i & 2047; const float c = s < 2 ? P.in[4][s * 2048 + k] : P.in[5][(s - 2) * 2048 + k]; sc[i] = silu_f(c); }
        __syncthreads();
        for (int cb = blockIdx.x; cb < 192; cb += gridDim.x) {
            const int cgp = tid & 7, ksl = tid >> 3, j = cb * 32 + cgp * 4;
            f32x4 acc[10];
#pragma unroll
            for (int s = 0; s < 10; ++s) acc[s] = (f32x4){0.f, 0.f, 0.f, 0.f};
            const float* w = P.in[6] + j;
#pragma unroll 8
            for (int i = 0; i < 32; ++i) { const int k = ksl + 64 * i; const f32x4 wv = __builtin_nontemporal_load((const f32x4*)(w + (size_t)k * 6144));
#pragma unroll
                for (int s = 0; s < 10; ++s) acc[s] += wv * sc[s * 2048 + k]; }
#pragma unroll
            for (int s = 0; s < 10; ++s)
#pragma unroll
                for (int e = 0; e < 4; ++e) { float v = acc[s][e]; v += __shfl_xor(v, 8); v += __shfl_xor(v, 16); v += __shfl_xor(v, 32); acc[s][e] = v; }
            if (lane < 8) {
#pragma unroll
                for (int s = 0; s < 10; ++s) *(LAS f32x4*)(red + (wave * 10 + s) * 32 + cgp * 4) = acc[s]; }
            __syncthreads();
            if (tid < 320) { const int s = tid >> 5, jj = tid & 31; float v = 0.f;
#pragma unroll
                for (int q = 0; q < 8; ++q) v += red[(q * 10 + s) * 32 + jj];
                mods[s * 6144 + cb * 32 + jj] = v + P.in[7][cb * 32 + jj]; }
            asm volatile("s_waitcnt vmcnt(0)" ::: "memory");
            __syncthreads();
            if (tid == 0) { __builtin_amdgcn_fence(__ATOMIC_RELEASE, "agent"); asm volatile("s_waitcnt vmcnt(0)" ::: "memory"); xb_add((unsigned*)(P.ws + WS_CNT) + 64 * 48, 1u); }
        }
    }
    __syncthreads();
    LAS float* scr = (LAS float*)(lds + wave * 8448);
    const int gw = blockIdx.x * 8 + wave, NGW = gridDim.x * 8;
    constexpr int I_IN = 32 * 488, I_SQ = 32 * 64, NIT = I_IN + 3 * I_SQ;
    bf16_t* Win = (bf16_t*)(P.ws + WS_WIN); bf16_t* Wb = (bf16_t*)(P.ws + WS_WB);
    struct TItem { const float* src; const float* ksc; bf16_t* dst; bf16_t* dstf; int ldw; int zero; };
    auto decode = [&](int it, TItem& t) {
        const float* W; int ldw, nbsrc, nbdst, kb; bf16_t* dst; const float* ksc = nullptr;
        if (it < I_IN) { kb = it / 488; nbdst = it % 488; nbsrc = nbdst < 160 ? nbdst : (nbdst < 480 ? nbdst + 1 : (nbdst == 480 ? 160 : -1)); W = P.in[9]; ldw = 15392; dst = Win; }
        else { int r = it - I_IN; const int m = r / I_SQ; r -= m * I_SQ; kb = r / 64; nbdst = r % 64; nbsrc = nbdst; ldw = 2048; W = m == 0 ? P.in[20] : (m == 1 ? P.in[21] : P.in[22]); dst = Wb + (size_t)m * 2048 * 2048; if (m == 0) ksc = P.in[15]; }
        t.zero = nbsrc < 0; t.ldw = ldw; t.ksc = ksc ? ksc + kb * 64 : nullptr;
        t.src = W + (size_t)(kb * 64) * ldw + (t.zero ? 0 : nbsrc * 32);
        t.dst = dst + (size_t)(nbdst * 32) * KD + kb * 64;
        t.dstf = it < I_IN ? nullptr : (bf16_t*)(P.ws + WS_WF) + (size_t)((it - I_IN) / I_SQ) * 2048 * 2048 + ((size_t)(kb * 8) * 2048 + nbdst * 32) * 8;
    };
    auto issue = [&](const TItem& t, f32x4 (&v)[8]) {
#pragma unroll
        for (int i = 0; i < 8; ++i) { const int kk = 8 * i + (lane >> 3), nn = (lane & 7) * 4; v[i] = __builtin_nontemporal_load((const f32x4*)(t.src + (size_t)kk * t.ldw + nn)); }
    };
    const int c8 = lane & 7;
    TItem cur; f32x4 v[8];
    int it = gw;
    if (it < NIT) { decode(it, cur); issue(cur, v); }
    while (it < NIT) {
        const int itn = it + NGW; TItem nxt = cur; f32x4 vn[8];
        if (itn < NIT) { decode(itn, nxt); issue(nxt, vn); }
        else {
#pragma unroll
            for (int i = 0; i < 8; ++i) vn[i] = (f32x4){0.f, 0.f, 0.f, 0.f}; }
#pragma unroll
        for (int i = 0; i < 8; ++i) { const int kk = 8 * i + (lane >> 3), nn = (lane & 7) * 4; f32x4 x = v[i]; if (cur.ksc) x = x * cur.ksc[kk]; if (cur.zero) x = (f32x4){0.f, 0.f, 0.f, 0.f};
            scr[kk * 33 + nn] = x.x; scr[kk * 33 + nn + 1] = x.y; scr[kk * 33 + nn + 2] = x.z; scr[kk * 33 + nn + 3] = x.w; }
        asm volatile("s_waitcnt lgkmcnt(0)" ::: "memory");
#pragma unroll
        for (int j = 0; j < 4; ++j) { const int n = (lane >> 3) + 8 * j; const LAS float* sp = scr + (8 * c8) * 33 + n;
            u32x4 o; o.x = pk2(sp[0 * 33], sp[1 * 33]); o.y = pk2(sp[2 * 33], sp[3 * 33]); o.z = pk2(sp[4 * 33], sp[5 * 33]); o.w = pk2(sp[6 * 33], sp[7 * 33]);
            *(u32x4*)(cur.dst + (size_t)n * KD + 8 * c8) = o;
            if (cur.dstf) *(u32x4*)(cur.dstf + ((size_t)c8 * 2048 + n) * 8) = o; }
        asm volatile("s_waitcnt lgkmcnt(0)" ::: "memory");
        cur = nxt; it = itn;
#pragma unroll
        for (int i = 0; i < 8; ++i) v[i] = vn[i];
    }
}

__device__ __forceinline__ void phase1(const Params& P) {
    const int tid = threadIdx.x, lane = tid & 63, wave = tid >> 6;
    if (tid == 0) { unsigned* c = (unsigned*)(P.ws + WS_CNT) + 64 * 48; unsigned sp = 0u;
        while (xb_ld(c) < 192u) { __builtin_amdgcn_s_sleep(1); if (++sp > (1u << 22)) break; }
        __builtin_amdgcn_fence(__ATOMIC_ACQUIRE, "agent"); asm volatile("s_waitcnt vmcnt(0)" ::: "memory"); }
    __syncthreads();
    const int gw = blockIdx.x * 8 + wave, NGW = gridDim.x * 8;
    const float* mods = (const float*)(P.ws + WS_MODS); bf16_t* H = (bf16_t*)(P.ws + WS_H);
    auto xrow = [&](int r) { return r < TP ? P.in[0] + (size_t)r * DM : P.in[1] + (size_t)(r - TP) * DM; };
    f32x4 v[8];
    if (gw < T) { const float* xr = xrow(gw);
#pragma unroll
        for (int j = 0; j < 8; ++j) v[j] = __builtin_nontemporal_load((const f32x4*)xr + 2 * lane + (j & 1) + 128 * (j >> 1)); }
    for (int r = gw; r < T; r += NGW) {
        const int s = stream_of(r);
        f32x4 vn[8];
        if (r + NGW < T) { const float* xn = xrow(r + NGW);
#pragma unroll
            for (int j = 0; j < 8; ++j) vn[j] = __builtin_nontemporal_load((const f32x4*)xn + 2 * lane + (j & 1) + 128 * (j >> 1)); }
        else {
#pragma unroll
            for (int j = 0; j < 8; ++j) vn[j] = (f32x4){0.f, 0.f, 0.f, 0.f}; }
        float ss = 0.f;
#pragma unroll
        for (int j = 0; j < 8; ++j) ss += (v[j].x * v[j].x + v[j].y * v[j].y) + (v[j].z * v[j].z + v[j].w * v[j].w);
        ss = wave_sum(ss);
        const float rstd = rsqrtf(ss * (1.f / DM) + EPS);
        const float* ms = mods + s * 6144;
#pragma unroll
        for (int jj = 0; jj < 4; ++jj) { u32x4 o;
#pragma unroll
            for (int k2 = 0; k2 < 2; ++k2) { const int j = 2 * jj + k2, col = (2 * lane + k2 + 128 * jj) * 4;
                const f32x4 g = *(const f32x4*)(P.in[8] + col), sh = *(const f32x4*)(ms + col), sl = *(const f32x4*)(ms + 2048 + col);
                const f32x4 h = v[j] * rstd * g * (sl + 1.f) + sh;
                if (k2 == 0) { o.x = pk2(h.x, h.y); o.y = pk2(h.z, h.w); } else { o.z = pk2(h.x, h.y); o.w = pk2(h.z, h.w); } }
            *(u32x4*)(H + (size_t)r * DM + (2 * lane + 128 * jj) * 4) = o; }
#pragma unroll
        for (int j = 0; j < 8; ++j) v[j] = vn[j];
    }
}

struct SchedIn {
    int nM, nN, nwg, G, c; const char* A; const char* B;
    __device__ __forceinline__ bool next(int i, Unit& u) const {
        const long L = (long)i * G + c; if (L >= nwg) return false;
        int wgid = (int)L; { const int q = nwg / 8, r = nwg % 8, xcd = wgid % 8, off = wgid / 8; wgid = (xcd < r ? xcd * (q + 1) : r * (q + 1) + (xcd - r) * q) + off; }
        const int nig = 8 * nN, gid = wgid / nig, fm = gid * 8, gsz = (nM - fm) < 8 ? (nM - fm) : 8;
        u.pm = fm + ((wgid % nig) % gsz); u.pn = (wgid % nig) / gsz; u.w = 0; u.pad = 0;
        u.a = A + (size_t)u.pm * 256 * (KD * 2); u.b = B + (size_t)u.pn * 256 * (KD * 2); return true;
    }
};
struct EpiIn {
    static constexpr bool PERM = true;
    bf16_t* proj; float* dt; const float* dt_bias;
    __device__ __forceinline__ bool operator()(const f32x4 (&acc)[2][2][4][2], const Unit& u, int wr, int wc, int fr, int fq) const {
        const int row0 = u.pm * 256 + wr * 64 + fr;
        if (u.pn < 60) {
            const int col0 = u.pn * 256 + wc * 32 + 8 * fq; const bool frag = pn_is_frag(u.pn);
#pragma unroll
            for (int ai = 0; ai < 2; ++ai)
#pragma unroll
                for (int m = 0; m < 4; ++m) { const int row = row0 + ai * 128 + m * 16;
#pragma unroll
                    for (int bj = 0; bj < 2; ++bj) { const f32x4 v0 = acc[ai][bj][m][0], v1 = acc[ai][bj][m][1];
                        u32x4 w; w.x = pk2(v0[0], v0[1]); w.y = pk2(v0[2], v0[3]); w.z = pk2(v1[0], v1[1]); w.w = pk2(v1[2], v1[3]);
                        *(u32x4*)(proj + (frag ? pjf(row, col0 + bj * 128) : pj(row, col0 + bj * 128))) = w; } }
        } else if (wc == 0) {
            const f32x4 b0 = *(const f32x4*)(dt_bias + 8 * fq), b1 = *(const f32x4*)(dt_bias + 8 * fq + 4);
#pragma unroll
            for (int ai = 0; ai < 2; ++ai)
#pragma unroll
                for (int m = 0; m < 4; ++m) { float* dp = dt + (size_t)(row0 + ai * 128 + m * 16) * 32 + 8 * fq;
                    f32x4 v0 = acc[ai][0][m][0] + b0, v1 = acc[ai][0][m][1] + b1;
#pragma unroll
                    for (int e = 0; e < 4; ++e) { v0[e] = v0[e] > 20.f ? v0[e] : __logf(1.f + __expf(v0[e])); v1[e] = v1[e] > 20.f ? v1[e] : __logf(1.f + __expf(v1[e])); }
                    *(f32x4*)dp = v0; *(f32x4*)(dp + 4) = v1; }
        }
        return true;
    }
};


template <bool SAMP>
__device__ __forceinline__ void conv16(const u32x4 (&raw)[19], const f32x4 (&hs)[3][2], const float (&w)[4][8], const float (&bias)[8], int j0, bool zero_hist, int nv,
                                       LAS unsigned char* dst, int dstride, bool wr_state, float* cst) {
    float win[4][8];
#pragma unroll
    for (int r = 0; r < 19; ++r) {
        const int j = j0 + r - 3;
        const u32x4 q = raw[r];
        float* cur = win[r & 3];
        cur[0] = bflo(q.x); cur[1] = bfhi(q.x); cur[2] = bflo(q.y); cur[3] = bfhi(q.y); cur[4] = bflo(q.z); cur[5] = bfhi(q.z); cur[6] = bflo(q.w); cur[7] = bfhi(q.w);
        if (r < 3) {
            const bool hz = j < 0 && zero_hist;
            if (SAMP) { const bool hh = j < 0;
                cur[0] = hh ? hs[r < 3 ? r : 0][0].x : cur[0]; cur[1] = hh ? hs[r < 3 ? r : 0][0].y : cur[1]; cur[2] = hh ? hs[r < 3 ? r : 0][0].z : cur[2]; cur[3] = hh ? hs[r < 3 ? r : 0][0].w : cur[3];
                cur[4] = hh ? hs[r < 3 ? r : 0][1].x : cur[4]; cur[5] = hh ? hs[r < 3 ? r : 0][1].y : cur[5]; cur[6] = hh ? hs[r < 3 ? r : 0][1].z : cur[6]; cur[7] = hh ? hs[r < 3 ? r : 0][1].w : cur[7]; }
            else {
#pragma unroll
                for (int e = 0; e < 8; ++e) cur[e] = hz ? 0.f : cur[e]; }
        }
        if (SAMP) { const bool oob = j >= nv;
#pragma unroll
            for (int e = 0; e < 8; ++e) cur[e] = oob ? 0.f : cur[e]; }
        if (r >= 3) {
            const float* p3 = win[(r - 3) & 3]; const float* p2 = win[(r - 2) & 3]; const float* p1 = win[(r - 1) & 3];
            float o[8];
#pragma unroll
            for (int e = 0; e < 8; ++e) { const float t = __builtin_fmaf(w[3][e], cur[e], __builtin_fmaf(w[2][e], p1[e], __builtin_fmaf(w[1][e], p2[e], __builtin_fmaf(w[0][e], p3[e], bias[e]))));
                o[e] = silu_f(t); if (SAMP) o[e] = j < nv ? o[e] : 0.f; }
            u32x4 pk; pk.x = pk2(o[0], o[1]); pk.y = pk2(o[2], o[3]); pk.z = pk2(o[4], o[5]); pk.w = pk2(o[6], o[7]);
            *(LAS u32x4*)(dst + j * dstride) = pk;
            if (wr_state) { if (j >= nv - 3 && j < nv) { float* d = cst + (size_t)(j - (nv - 3)) * 3072;
                    *(f32x4*)d = (f32x4){cur[0], cur[1], cur[2], cur[3]}; *(f32x4*)(d + 4) = (f32x4){cur[4], cur[5], cur[6], cur[7]}; } }
        }
    }
}
constexpr int A_XC = 0, A_XCS = 1040, A_BM = 66560, A_CM = 83968, A_ST = 272, A_CBF = 101376, A_DTL = 118784, A_ACU = 120832;
__device__ __forceinline__ void ssd_item(const Params& P, LAS unsigned char* lds, unsigned ldsaddr, int ck, int g) {
    int tid_ = threadIdx.x; asm volatile("" : "+v"(tid_));
    const int tid = tid_, lane = tid & 63, wave = __builtin_amdgcn_readfirstlane(tid >> 6), fr = lane & 15, fq = lane >> 4;
    const bool samp = ck >= 128;
    int row0, nv, c, sidx;
    if (!samp) { sidx = ck >> 6; c = ck & 63; row0 = sidx * 4096 + c * 64; nv = 64; } else { sidx = ck - 128; c = 0; row0 = TP + sidx * 32; nv = 32; }
    const bf16_t* proj = (const bf16_t*)(P.ws + WS_PROJ);
    const float* DT = (const float*)(P.ws + WS_DT); float* EAC = (float*)(P.ws + WS_EAC); float* BDEC = (float*)(P.ws + WS_BDEC);
    bf16_t* YP = (bf16_t*)(P.ws + WS_YP); bf16_t* CPOST = (bf16_t*)(P.ws + WS_CPOST); bf16_t* S = (bf16_t*)(P.ws + WS_S);
    LAS float* DTL = (LAS float*)(lds + A_DTL); LAS float* ACU = (LAS float*)(lds + A_ACU);
    const bool act = tid < 384;
    {
        const int tcl = act ? tid : tid - 384;
        const int cg = tcl % 96, seg = tcl / 96, j0 = seg * 16;
        int ch0, dstoff, dstride;
        if (cg < 64) { ch0 = g * 512 + cg * 8; dstoff = A_XC + cg * 16; dstride = A_XCS; }
        else if (cg < 80) { ch0 = 2048 + g * 128 + (cg - 64) * 8; dstoff = A_BM + (cg - 64) * 16; dstride = A_ST; }
        else { ch0 = 2560 + g * 128 + (cg - 80) * 8; dstoff = A_CM + (cg - 80) * 16; dstride = A_ST; }
        float w[4][8], bias[8];
#pragma unroll
        for (int k = 0; k < 4; ++k) { const f32x4 a = *(const f32x4*)(P.in[10] + k * 3072 + ch0), b = *(const f32x4*)(P.in[10] + k * 3072 + ch0 + 4);
            w[k][0] = a.x; w[k][1] = a.y; w[k][2] = a.z; w[k][3] = a.w; w[k][4] = b.x; w[k][5] = b.y; w[k][6] = b.z; w[k][7] = b.w; }
        { const f32x4 a = *(const f32x4*)(P.in[11] + ch0), b = *(const f32x4*)(P.in[11] + ch0 + 4);
            bias[0] = a.x; bias[1] = a.y; bias[2] = a.z; bias[3] = a.w; bias[4] = b.x; bias[5] = b.y; bias[6] = b.z; bias[7] = b.w; }
        float p3[8], p2[8], p1[8];
#pragma unroll
        for (int e = 0; e < 8; ++e) { p3[e] = 0.f; p2[e] = 0.f; p1[e] = 0.f; }
        const bf16_t* src = proj + pj(row0, C_XS + ch0);
        const bool wr_state = samp || c == 63;
        float* cst = samp ? P.out + O_CONVS + (size_t)sidx * 3 * 3072 + ch0 : P.out + O_CONVP + (size_t)sidx * 3 * 3072 + ch0;
        u32x4 raw[19];
#pragma unroll
        for (int r = 0; r < 19; ++r) { const int j = j0 + r - 3; int jc = j < nv ? j : nv - 1; if ((samp || c == 0) && jc < 0) jc = 0; raw[r] = act ? *(const u32x4*)(src + (long)jc * 256) : (u32x4){0u, 0u, 0u, 0u}; }
        f32x4 hs[3][2];
#pragma unroll
        for (int r = 0; r < 3; ++r) { hs[r][0] = hs[r][1] = (f32x4){0.f, 0.f, 0.f, 0.f}; }
        if (samp) {
#pragma unroll
            for (int r = 0; r < 3; ++r) { const float* hp = P.in[3] + ((size_t)sidx * 3 + r) * 3072 + ch0; hs[r][0] = *(const f32x4*)hp; hs[r][1] = *(const f32x4*)(hp + 4); } }
        if (!act) {
            float dtv[4];
#pragma unroll
            for (int hq = 0; hq < 4; ++hq) { const int h = g * 8 + (wave - 6) * 4 + hq; dtv[hq] = lane < nv ? DT[(size_t)(row0 + lane) * 32 + h] : 0.f; }
#pragma unroll
            for (int hq = 0; hq < 4; ++hq) {
                const int hh = (wave - 6) * 4 + hq, h = g * 8 + hh, j = lane;
                const float dt = dtv[hq];
                const float a = -expf(P.in[13][h]);
                float x = dt * a;
#pragma unroll
                for (int o = 1; o < 64; o <<= 1) { const float y = __shfl_up(x, o); if (lane >= o) x += y; }
                DTL[hh * 64 + j] = dt; ACU[hh * 64 + j] = x;
                if (j < nv) EAC[(size_t)(row0 + j) * 32 + h] = __expf(x);
                const float last = __shfl(x, 63);
                if (lane == 0) BDEC[ck * 32 + h] = __expf(last);
            }
        }
        if (act) {
            if (samp) conv16<true>(raw, hs, w, bias, j0, false, nv, lds + dstoff, dstride, true, cst);
            else conv16<false>(raw, hs, w, bias, j0, c == 0, nv, lds + dstoff, dstride, wr_state, cst);
        }
    }
    __syncthreads();
    for (int q = tid; q < 1024; q += 512) { const int j = q & 63, n8 = q >> 6;
        if (j < nv) *(u32x4*)(CPOST + (size_t)(ck * 4 + g) * 8192 + (n8 * 64 + j) * 8) = *(const LAS u32x4*)(lds + A_CM + j * A_ST + n8 * 16); }
    for (int t2 = wave; t2 < 16; t2 += 8) {
        const int it = t2 >> 2, jt = t2 & 3;
        if (jt > it) continue;
        f32x4 acc = (f32x4){0.f, 0.f, 0.f, 0.f};
#pragma unroll
        for (int ks = 0; ks < 4; ++ks) { const bf16x8 a = rowfrag(lds + A_BM, jt * 16, A_ST, ks * 32, fr, fq), b = rowfrag(lds + A_CM, it * 16, A_ST, ks * 32, fr, fq); acc = mma16(a, b, acc); }
        *(LAS f32x4*)(lds + A_CBF + (it * 16 + fr) * 272 + (jt * 16 + fq * 4) * 4) = acc;
    }
    __syncthreads();
    {
        const int hh = wave, h = g * 8 + hh; const float dsk = P.in[14][h];
        bf16x8 xf[4][2];
        tr8_xc(ldsaddr + A_XC + hh * 128, lane, xf);
        float wj[2][8];
        const float alast = ACU[hh * 64 + 63];
#pragma unroll
        for (int ks = 0; ks < 2; ++ks) { const int jb = ks * 32 + fq * 8;
            const f32x4 aj0 = *(const LAS f32x4*)(ACU + hh * 64 + jb), aj1 = *(const LAS f32x4*)(ACU + hh * 64 + jb + 4);
            const f32x4 dt0 = *(const LAS f32x4*)(DTL + hh * 64 + jb), dt1 = *(const LAS f32x4*)(DTL + hh * 64 + jb + 4);
            wj[ks][0] = dt0.x * __expf(alast - aj0.x); wj[ks][1] = dt0.y * __expf(alast - aj0.y); wj[ks][2] = dt0.z * __expf(alast - aj0.z); wj[ks][3] = dt0.w * __expf(alast - aj0.w);
            wj[ks][4] = dt1.x * __expf(alast - aj1.x); wj[ks][5] = dt1.y * __expf(alast - aj1.y); wj[ks][6] = dt1.z * __expf(alast - aj1.z); wj[ks][7] = dt1.w * __expf(alast - aj1.w); }
#pragma unroll
        for (int it = 0; it < 4; ++it) {
            if (it * 16 >= nv) break;
            const int i = it * 16 + fr; const float ai = ACU[hh * 64 + i];
            f32x4 ya[4];
#pragma unroll
            for (int pt = 0; pt < 4; ++pt) ya[pt] = (f32x4){0.f, 0.f, 0.f, 0.f};
#pragma unroll
            for (int ks = 0; ks < 2; ++ks) {
                if (ks * 32 > it * 16 + 15) continue;
                const int jb = ks * 32 + fq * 8;
                const f32x4 aj0 = *(const LAS f32x4*)(ACU + hh * 64 + jb), aj1 = *(const LAS f32x4*)(ACU + hh * 64 + jb + 4);
                const f32x4 dt0 = *(const LAS f32x4*)(DTL + hh * 64 + jb), dt1 = *(const LAS f32x4*)(DTL + hh * 64 + jb + 4);
                const f32x4 cb0 = *(const LAS f32x4*)(lds + A_CBF + i * 272 + jb * 4), cb1 = *(const LAS f32x4*)(lds + A_CBF + i * 272 + jb * 4 + 16);
                const float aj[8] = {aj0.x, aj0.y, aj0.z, aj0.w, aj1.x, aj1.y, aj1.z, aj1.w};
                const float dj[8] = {dt0.x, dt0.y, dt0.z, dt0.w, dt1.x, dt1.y, dt1.z, dt1.w};
                const float cb[8] = {cb0.x, cb0.y, cb0.z, cb0.w, cb1.x, cb1.y, cb1.z, cb1.w};
                float m[8];
#pragma unroll
                for (int e = 0; e < 8; ++e) { const int j = jb + e; float v = (j <= i) ? cb[e] * __expf(ai - aj[e]) * dj[e] : 0.f; if (j == i) v += dsk; m[e] = v; }
                const bf16x8 mf = pack8(m);
#pragma unroll
                for (int pt = 0; pt < 4; ++pt) ya[pt] = mma16(xf[pt][ks], mf, ya[pt]);
            }
#pragma unroll
            for (int pp = 0; pp < 2; ++pp) { u32x4 o; o.x = pk2(ya[2 * pp][0], ya[2 * pp][1]); o.y = pk2(ya[2 * pp][2], ya[2 * pp][3]); o.z = pk2(ya[2 * pp + 1][0], ya[2 * pp + 1][1]); o.w = pk2(ya[2 * pp + 1][2], ya[2 * pp + 1][3]);
                *(u32x4*)(YP + (size_t)(ck * 32 + h) * 4096 + ((pp * 4 + fq) * 64 + i) * 8) = o; }
        }
#pragma unroll
        for (int pt = 0; pt < 4; ++pt)
#pragma unroll
            for (int ks = 0; ks < 2; ++ks) { const u32x4 xu = __builtin_bit_cast(u32x4, xf[pt][ks]);
                float xs[8] = {bflo(xu.x) * wj[ks][0], bfhi(xu.x) * wj[ks][1], bflo(xu.y) * wj[ks][2], bfhi(xu.y) * wj[ks][3], bflo(xu.z) * wj[ks][4], bfhi(xu.z) * wj[ks][5], bflo(xu.w) * wj[ks][6], bfhi(xu.w) * wj[ks][7]};
                xf[pt][ks] = pack8(xs); }
        bf16_t* sp = S + (size_t)(ck * 32 + h) * 8192;
#pragma unroll
        for (int nh = 0; nh < 2; ++nh) {
            bf16x8 bfr[4][2];
            tr8_bm(ldsaddr + A_BM + nh * 128, lane, bfr);
#pragma unroll
            for (int np = 0; np < 2; ++np)
#pragma unroll
                for (int pt = 0; pt < 4; ++pt) { u32x2 oo[2];
#pragma unroll
                    for (int k2 = 0; k2 < 2; ++k2) { const int nt = 2 * np + k2; f32x4 sa = mma16(bfr[nt][0], xf[pt][0], (f32x4){0.f, 0.f, 0.f, 0.f}); sa = mma16(bfr[nt][1], xf[pt][1], sa);
                        oo[k2].x = pk2(sa[0], sa[1]); oo[k2].y = pk2(sa[2], sa[3]); }
                    const u32x4 w = widen16(oo[0], oo[1]);
                    *(u32x4*)(sp + (((nh * 4 + 2 * np + (fq & 1)) * 2 + (fq >> 1)) * 64 + pt * 16 + fr) * 8) = w; }
        }
    }
    __syncthreads();
}
__device__ __forceinline__ void ln_item(const Params& P, int idx) {
    const int tid = threadIdx.x, lane = tid & 63, wave = tid >> 6;
    const bf16_t* proj = (const bf16_t*)(P.ws + WS_PROJ); float* LNS = (float*)(P.ws + WS_LNS);
    for (int q = 0; q < 5; ++q) {
        const int r = idx * 38 + wave + 8 * q;
        if (r >= T || r >= (idx + 1) * 38) break;
        u32x4 raw[4]; float s = 0.f;
#pragma unroll
        for (int j = 0; j < 4; ++j) { raw[j] = *(const u32x4*)(proj + pj(r, C_V + (lane + 64 * j) * 8)); s += (bflo(raw[j].x) + bfhi(raw[j].x)) + (bflo(raw[j].y) + bfhi(raw[j].y)) + (bflo(raw[j].z) + bfhi(raw[j].z)) + (bflo(raw[j].w) + bfhi(raw[j].w)); }
        const float mean = wave_sum(s) * (1.f / 2048.f); float s2 = 0.f;
#pragma unroll
        for (int j = 0; j < 4; ++j) { float d;
            d = bflo(raw[j].x) - mean; s2 += d * d; d = bfhi(raw[j].x) - mean; s2 += d * d; d = bflo(raw[j].y) - mean; s2 += d * d; d = bfhi(raw[j].y) - mean; s2 += d * d;
            d = bflo(raw[j].z) - mean; s2 += d * d; d = bfhi(raw[j].z) - mean; s2 += d * d; d = bflo(raw[j].w) - mean; s2 += d * d; d = bfhi(raw[j].w) - mean; s2 += d * d; }
        const float rstd = rsqrtf(wave_sum(s2) * (1.f / 2048.f) + EPS);
        if (lane == 0) { LNS[r * 2] = mean; LNS[r * 2 + 1] = rstd; }
    }
}
__device__ __forceinline__ void phase3(const Params& P, LAS unsigned char* lds, unsigned ldsaddr) {
#if DUPK == 31
    for (int it = blockIdx.x; it < 132; it += gridDim.x) ln_item(P, it);
#endif
#if DUPK == 32
    for (int it = blockIdx.x; it < 544; it += gridDim.x) ssd_item(P, lds, ldsaddr, it >> 2, it & 3);
#endif
    for (int it = blockIdx.x; it < 544 + 224; it += gridDim.x) {
        if (it < 544) ssd_item(P, lds, ldsaddr, it >> 2, it & 3); else ln_item(P, it - 544);
    }
}

template <bool DRY> __device__ __forceinline__ void scan_prompt_item(const Params& P, int item) {
    const int idx = item * 512 + threadIdx.x, n4 = idx & 31, p = (idx >> 5) & 63, h = (idx >> 11) & 31, s = idx >> 16;
    bf16_t* S = (bf16_t*)(P.ws + WS_S); bf16_t* SD = DRY ? (bf16_t*)(P.ws + WS_YZ) : S; const float* BDEC = (const float*)(P.ws + WS_BDEC);
    f32x4 hst = (f32x4){0.f, 0.f, 0.f, 0.f};
    bf16_t* sp0 = S + ((size_t)(s * 64 * 32 + h) * 64 + p) * 128 + n4 * 4;
    const float* bd0 = BDEC + (s * 64) * 32 + h;
    u32x2 raw[2][16]; float d[2][16];
#pragma unroll
    for (int q = 0; q < 16; ++q) { raw[0][q] = *(const u32x2*)(sp0 + (size_t)q * 262144); d[0][q] = bd0[q * 32]; }
#pragma unroll
    for (int b = 0; b < 4; ++b) {
        if (b < 3) {
#pragma unroll
            for (int q = 0; q < 16; ++q) { raw[(b + 1) & 1][q] = *(const u32x2*)(sp0 + (size_t)((b + 1) * 16 + q) * 262144); d[(b + 1) & 1][q] = bd0[((b + 1) * 16 + q) * 32]; } }
#pragma unroll
        for (int q = 0; q < 16; ++q) {
            u32x2 o; o.x = pk2(hst.x, hst.y); o.y = pk2(hst.z, hst.w);
            bf16_t* dst = DRY ? SD + (((size_t)((s * 64 + b * 16 + q) * 32 + h) * 64 + p) * 128 + n4 * 4) % (size_t)16777216 : sp0 + (size_t)(b * 16 + q) * 262144;
            *(u32x2*)dst = o;
            const u32x2 rr = raw[b & 1][q];
            const f32x4 sv = (f32x4){bflo(rr.x), bfhi(rr.x), bflo(rr.y), bfhi(rr.y)};
            hst = hst * d[b & 1][q] + sv; }
    }
    { const int f = p * 128 + n4 * 4, nb = f >> 9, pp = (f >> 3) & 63, e0 = f & 7;
      if (!DRY) *(f32x4*)(P.out + O_SSMP + ((size_t)(s * 32 + h) * 64 + pp) * 128 + nb * 8 + e0) = hst;
      else if (hst.x == 1.2345f) P.out[0] = 0.f; }
}
__device__ __forceinline__ void scan_sample_item(const Params& P, int item) {
    const bf16_t* S = (const bf16_t*)(P.ws + WS_S); const float* BDEC = (const float*)(P.ws + WS_BDEC);
#pragma unroll
    for (int q = 0; q < 4; ++q) {
        const int e = item * 512 + threadIdx.x + q * 131072, n4 = e & 31, p = (e >> 5) & 63, h = (e >> 11) & 31, sb = e >> 16;
        const int f = p * 128 + n4 * 4, nb = f >> 9, pp = (f >> 3) & 63, e0 = f & 7;
        const size_t off = ((size_t)(sb * 32 + h) * 64 + pp) * 128 + nb * 8 + e0;
        const f32x4 h0 = *(const f32x4*)(P.in[2] + off);
        const int ck = 128 + sb;
        const u32x2 raw = *(const u32x2*)(S + ((size_t)(ck * 32 + h) * 64 + p) * 128 + n4 * 4);
        const float d = BDEC[ck * 32 + h];
        const f32x4 sv = (f32x4){bflo(raw.x), bfhi(raw.x), bflo(raw.y), bfhi(raw.y)};
        *(f32x4*)(P.out + O_SSMS + off) = h0 * d + sv;
    }
}
__device__ __forceinline__ void wf_item(const Params& P, LAS unsigned char* lds, int m, int nb) {
    int tid = threadIdx.x; asm volatile("" : "+v"(tid));
    const u32x4* src = (const u32x4*)((const bf16_t*)(P.ws + WS_WB) + (size_t)m * 2048 * 2048 + (size_t)nb * 32 * KD);
    u32x4* dst = (u32x4*)((bf16_t*)(P.ws + WS_WF) + (size_t)m * 2048 * 2048);
    u32x4 v[16];
#pragma unroll
    for (int i = 0; i < 16; ++i) v[i] = src[tid + 512 * i];
#pragma unroll
    for (int i = 0; i < 16; ++i) { const int p = tid + 512 * i, n = p >> 8, kg = p & 255; *(LAS u32x4*)(lds + (kg * 33 + n) * 16) = v[i]; }
    __syncthreads();
#pragma unroll
    for (int i = 0; i < 16; ++i) { const int p = tid + 512 * i, kg = p >> 5, n = p & 31; dst[(size_t)kg * 2048 + nb * 32 + n] = *(const LAS u32x4*)(lds + (kg * 33 + n) * 16); }
    __syncthreads();
}
constexpr int B_VN = 0, B_VNS = 528, B_WS = 67584, B_WSS = 272;
__device__ __forceinline__ void gmlp_item(const Params& P, LAS unsigned char* lds, unsigned ldsaddr, int rowbase, int nv, int grp, int sb) {
    int tid_ = threadIdx.x; asm volatile("" : "+v"(tid_));
    const int tid = tid_, lane = tid & 63, wave = __builtin_amdgcn_readfirstlane(tid >> 6), fr = lane & 15, fq = lane >> 4;
    const bf16_t* proj = (const bf16_t*)(P.ws + WS_PROJ); const float* LNS = (const float*)(P.ws + WS_LNS); bf16_t* ymlp = (bf16_t*)(P.ws + WS_YMLP);
    {
        const float* wsp = P.in[18] + (size_t)grp * 128 * 128;
#pragma unroll
        for (int k = 0; k < 8; ++k) { const int q = tid + 512 * k, i = q >> 5, j4 = (q & 31) * 4;
            const f32x4 v = *(const f32x4*)(wsp + i * 128 + j4);
            u32x2 o; o.x = pk2(j4 <= i ? v.x : 0.f, j4 + 1 <= i ? v.y : 0.f); o.y = pk2(j4 + 2 <= i ? v.z : 0.f, j4 + 3 <= i ? v.w : 0.f);
            *(LAS u32x2*)(lds + B_WS + i * B_WSS + j4 * 2) = o; }
    }
    {
#pragma unroll
        for (int k = 0; k < 8; ++k) { const int q = tid + 512 * k, j = q >> 5, c8 = (q & 31) * 8;
            u32x4 o = (u32x4){0u, 0u, 0u, 0u};
            if (j < nv) {
                const int row = rowbase + j, ch = grp * 256 + c8;
                const u32x4 raw = *(const u32x4*)(proj + pj(row, C_V + ch));
                const float mean = LNS[row * 2], rstd = LNS[row * 2 + 1];
                const f32x4 g0 = *(const f32x4*)(P.in[16] + ch), g1 = *(const f32x4*)(P.in[16] + ch + 4), b0 = *(const f32x4*)(P.in[17] + ch), b1 = *(const f32x4*)(P.in[17] + ch + 4);
                f32x4 v0 = (f32x4){bflo(raw.x), bfhi(raw.x), bflo(raw.y), bfhi(raw.y)}, v1 = (f32x4){bflo(raw.z), bfhi(raw.z), bflo(raw.w), bfhi(raw.w)};
                v0 = (v0 - mean) * rstd * g0 + b0; v1 = (v1 - mean) * rstd * g1 + b1;
                o.x = pk2(v0.x, v0.y); o.y = pk2(v0.z, v0.w); o.z = pk2(v1.x, v1.y); o.w = pk2(v1.z, v1.w);
                if (sb >= 0) { float* vo = P.out + O_VS + ((size_t)sb * 32 + j) * 2048 + ch; *(f32x4*)vo = v0; *(f32x4*)(vo + 4) = v1; }
            }
            *(LAS u32x4*)(lds + B_VN + j * B_VNS + c8 * 2) = o; }
    }
    __syncthreads();
    const int pr = wave & 3, hf = wave >> 2, itA = pr, itB = 7 - pr;
    u32x4 upre[2][4], zpre[2][4];
#pragma unroll
    for (int t = 0; t < 2; ++t) { const int it = t ? itB : itA, i = it * 16 + fr, row = rowbase + (i < nv ? i : 0);
#pragma unroll
        for (int cp = 0; cp < 4; ++cp) { const int cc = grp * 256 + (hf * 8 + 2 * cp + (fq & 1)) * 16 + (fq >> 1) * 8;
            upre[t][cp] = *(const u32x4*)(proj + pjf(row, C_U + cc)); zpre[t][cp] = *(const u32x4*)(proj + pjf(row, C_ZM + cc)); } }
    f32x4 acc[2][8];
#pragma unroll
    for (int t = 0; t < 2; ++t)
#pragma unroll
        for (int ct = 0; ct < 8; ++ct) acc[t][ct] = (f32x4){0.f, 0.f, 0.f, 0.f};
#pragma unroll
    for (int ks = 0; ks < 4; ++ks) {
        if (ks * 32 >= nv) break;
        const bool vA = ks * 32 <= itA * 16 + 15, vB = ks * 32 <= itB * 16 + 15;
        if (!vA && !vB) continue;
        const bf16x8 wA = rowfrag(lds + B_WS, itA * 16, B_WSS, ks * 32, fr, fq), wB = rowfrag(lds + B_WS, itB * 16, B_WSS, ks * 32, fr, fq);
        bf16x8 xv[8];
        tr8_vn(ldsaddr + B_VN + ks * 32 * B_VNS + hf * 8 * 32, lane, xv);
#pragma unroll
        for (int ct = 0; ct < 8; ++ct) {
            if (vA) acc[0][ct] = mma16(xv[ct], wA, acc[0][ct]);
            if (vB) acc[1][ct] = mma16(xv[ct], wB, acc[1][ct]); }
    }
#pragma unroll
    for (int t = 0; t < 2; ++t) { const int it = t ? itB : itA, i = it * 16 + fr;
        if (i < nv) { const int row = rowbase + i; const float bs = P.in[19][grp * 128 + i]; u32x2 go[8], uq[8], zq[8];
#pragma unroll
            for (int cp = 0; cp < 4; ++cp) { unwiden16(upre[t][cp], uq[2 * cp], uq[2 * cp + 1]); unwiden16(zpre[t][cp], zq[2 * cp], zq[2 * cp + 1]); }
#pragma unroll
            for (int ct = 0; ct < 8; ++ct) {
                const u32x2 uu = uq[ct], zz = zq[ct];
                const f32x4 a = acc[t][ct];
                const float y0 = bflo(uu.x) * (a[0] + bs) * silu_f(bflo(zz.x)), y1 = bfhi(uu.x) * (a[1] + bs) * silu_f(bfhi(zz.x));
                const float y2 = bflo(uu.y) * (a[2] + bs) * silu_f(bflo(zz.y)), y3 = bfhi(uu.y) * (a[3] + bs) * silu_f(bfhi(zz.y));
                go[ct].x = pk2(y0, y1); go[ct].y = pk2(y2, y3); }
#pragma unroll
            for (int cp = 0; cp < 4; ++cp) { const u32x4 w = widen16(go[2 * cp], go[2 * cp + 1]); const int ccw = grp * 256 + (hf * 8 + 2 * cp + (fq & 1)) * 16 + (fq >> 1) * 8;
                *(u32x4*)(ymlp + (size_t)row * DM + ccw) = w;
                if (sb >= 0) *(u32x4*)((bf16_t*)(P.ws + WS_AS) + (size_t)256 * 256 * 8 + pjs(row - TP, ccw)) = w; } } }
    __syncthreads();
}
__device__ __forceinline__ void phase4(const Params& P, LAS unsigned char* lds, unsigned ldsaddr) {
#if DUPK == 41
    for (int it = blockIdx.x; it < 256; it += gridDim.x) scan_prompt_item<true>(P, it);
#endif
#if DUPK == 40
    for (int it = blockIdx.x; it < 576; it += gridDim.x) {
        if (it < 512) { const int grp = it & 7, cc = (it >> 3) & 31, s = it >> 8; gmlp_item(P, lds, ldsaddr, s * 4096 + cc * 128, 128, grp, -1); }
        else { const int q = it - 512, grp = q & 7, sb = q >> 3; gmlp_item(P, lds, ldsaddr, TP + sb * 32, 32, grp, sb); }
    }
#endif
    for (int it = blockIdx.x; it < 1088; it += gridDim.x) {
        if (it < 512) { const int grp = it & 7, cc = (it >> 3) & 31, s = it >> 8; gmlp_item(P, lds, ldsaddr, s * 4096 + cc * 128, 128, grp, -1); }
        else if (it < 576) { const int q = it - 512, grp = q & 7, sb = q >> 3; gmlp_item(P, lds, ldsaddr, TP + sb * 32, 32, grp, sb); }
        else if (it < 832) scan_prompt_item<false>(P, it - 576);
        else scan_sample_item(P, it - 832);
    }
}

__device__ __forceinline__ void yoff_item(const Params& P, LAS unsigned char* lds, int ck, int g) {
    const int tid = threadIdx.x, lane = tid & 63, wave = __builtin_amdgcn_readfirstlane(tid >> 6), fr = lane & 15, fq = lane >> 4;
    const bool samp = ck >= 128;
    int row0, nv, sb = 0;
    if (!samp) { row0 = (ck >> 6) * 4096 + (ck & 63) * 64; nv = 64; } else { sb = ck - 128; row0 = TP + sb * 32; nv = 32; }
    const int hh = wave, h = g * 8 + hh;
    const bf16_t* proj = (const bf16_t*)(P.ws + WS_PROJ); bf16_t* YZ = (bf16_t*)(P.ws + WS_YZ); const bf16_t* S = (const bf16_t*)(P.ws + WS_S); const bf16_t* CPOST = (const bf16_t*)(P.ws + WS_CPOST);
    const bf16_t* YP = (const bf16_t*)(P.ws + WS_YP); const float* EAC = (const float*)(P.ws + WS_EAC); float* SSQ = (float*)(P.ws + WS_SSQ);
    bf16x8 hp[4][4];
    if (!samp) {
        const bf16_t* sp = S + (size_t)(ck * 32 + h) * 8192;
#pragma unroll
        for (int pt = 0; pt < 4; ++pt)
#pragma unroll
            for (int ks = 0; ks < 4; ++ks) hp[pt][ks] = *(const bf16x8*)(sp + ((ks * 4 + fq) * 64 + pt * 16 + fr) * 8);
    } else {
        const float* sp = P.in[2] + (size_t)(sb * 32 + h) * 8192;
#pragma unroll
        for (int pt = 0; pt < 4; ++pt)
#pragma unroll
            for (int ks = 0; ks < 4; ++ks) { const f32x4 a = *(const f32x4*)(sp + (pt * 16 + fr) * 128 + ks * 32 + fq * 8), b = *(const f32x4*)(sp + (pt * 16 + fr) * 128 + ks * 32 + fq * 8 + 4);
                u32x4 r; r.x = pk2(a.x, a.y); r.y = pk2(a.z, a.w); r.z = pk2(b.x, b.y); r.w = pk2(b.z, b.w); hp[pt][ks] = __builtin_bit_cast(bf16x8, r); }
    }
    LAS float* red = (LAS float*)lds;
    const int nit = nv >> 4;
    bf16x8 cf[4][4];
#pragma unroll
    for (int it = 0; it < 4; ++it) { const int il = (it < nit ? it * 16 + fr : fr);
#pragma unroll
        for (int ks = 0; ks < 4; ++ks) cf[it][ks] = *(const bf16x8*)(CPOST + (size_t)(ck * 4 + g) * 8192 + ((ks * 4 + fq) * 64 + il) * 8); }
    u32x4 ypre[2][2], zpre[2][2]; float eapre[2];
    { const int row = row0 + fr; eapre[0] = EAC[(size_t)row * 32 + h];
#pragma unroll
        for (int pt = 0; pt < 4; ++pt) { const int col = h * 64 + pt * 16 + fq * 4; if (!(pt & 1)) ypre[0][pt >> 1] = *(const u32x4*)(YP + (size_t)(ck * 32 + h) * 4096 + (((pt >> 1) * 4 + fq) * 64 + fr) * 8); if (!(pt & 1)) zpre[0][pt >> 1] = *(const u32x4*)(proj + pjf(row, C_ZS + h * 64 + (pt + (fq & 1)) * 16 + (fq >> 1) * 8)); } }
#pragma unroll
    for (int it = 0; it < 4; ++it) {
        if (it >= nit) break;
        const int i = it * 16 + fr, row = row0 + i;
        if (it + 1 < 4 && it + 1 < nit) { const int rn = row + 16; eapre[(it + 1) & 1] = EAC[(size_t)rn * 32 + h];
#pragma unroll
            for (int pt = 0; pt < 4; ++pt) { const int col = h * 64 + pt * 16 + fq * 4; if (!(pt & 1)) ypre[(it + 1) & 1][pt >> 1] = *(const u32x4*)(YP + (size_t)(ck * 32 + h) * 4096 + (((pt >> 1) * 4 + fq) * 64 + (it + 1) * 16 + fr) * 8); if (!(pt & 1)) zpre[(it + 1) & 1][pt >> 1] = *(const u32x4*)(proj + pjf(rn, C_ZS + h * 64 + (pt + (fq & 1)) * 16 + (fq >> 1) * 8)); } }
        f32x4 acc[4];
#pragma unroll
        for (int pt = 0; pt < 4; ++pt) acc[pt] = (f32x4){0.f, 0.f, 0.f, 0.f};
#pragma unroll
        for (int ks = 0; ks < 4; ++ks)
#pragma unroll
            for (int pt = 0; pt < 4; ++pt) acc[pt] = mma16(hp[pt][ks], cf[it][ks], acc[pt]);
        const float ea = eapre[it & 1]; float ssq = 0.f; u32x2 yo[4], zq[4];
        unwiden16(zpre[it & 1][0], zq[0], zq[1]); unwiden16(zpre[it & 1][1], zq[2], zq[3]);
#pragma unroll
        for (int pt = 0; pt < 4; ++pt) { const int col = h * 64 + pt * 16 + fq * 4;
            const u32x4 yq = ypre[it & 1][pt >> 1]; u32x2 yp; yp.x = (pt & 1) ? yq.z : yq.x; yp.y = (pt & 1) ? yq.w : yq.y; const u32x2 zz = zq[pt];
            const float y0 = (bflo(yp.x) + ea * acc[pt][0]) * silu_f(bflo(zz.x)), y1 = (bfhi(yp.x) + ea * acc[pt][1]) * silu_f(bfhi(zz.x));
            const float y2 = (bflo(yp.y) + ea * acc[pt][2]) * silu_f(bflo(zz.y)), y3 = (bfhi(yp.y) + ea * acc[pt][3]) * silu_f(bfhi(zz.y));
            ssq += (y0 * y0 + y1 * y1) + (y2 * y2 + y3 * y3);
            yo[pt].x = pk2(y0, y1); yo[pt].y = pk2(y2, y3); }
#pragma unroll
        for (int pp = 0; pp < 2; ++pp) { const u32x4 w = widen16(yo[2 * pp], yo[2 * pp + 1]); const int colw = h * 64 + (2 * pp + (fq & 1)) * 16 + (fq >> 1) * 8;
            *(u32x4*)(YZ + (size_t)row * DM + colw) = w;
            if (samp) *(u32x4*)((bf16_t*)(P.ws + WS_AS) + pjs(row - TP, colw)) = w; }
        ssq += __shfl_xor(ssq, 16); ssq += __shfl_xor(ssq, 32);
        if (fq == 0) red[hh * 64 + i] = ssq;
    }
    __syncthreads();
    if (tid < nv) { float v = 0.f;
#pragma unroll
        for (int q = 0; q < 8; ++q) v += red[q * 64 + tid];
        SSQ[(size_t)(row0 + tid) * 4 + g] = v; }
    __syncthreads();
}
__device__ __forceinline__ void phase5(const Params& P, LAS unsigned char* lds) {
    for (int it = blockIdx.x; it < 512; it += gridDim.x) yoff_item(P, lds, it >> 2, it & 3);
}
__device__ __forceinline__ void phase4b(const Params& P, LAS unsigned char* lds) {
    const int G = gridDim.x, first = G >= 64 ? G - 32 : 0, step = G >= 64 ? 32 : G;
    for (int e = (int)blockIdx.x - first; e < 32; e += step) if (e >= 0) yoff_item(P, lds, 128 + (e >> 2), e & 3);
}

struct SchedD {
    int G, c; const char* A0; const char* A1; const char* B0; const char* B1;
    __device__ __forceinline__ bool next(int i, Unit& u) const {
        const int L = (i >> 1) * G + c; if (L >= 256) return false;
        { const int xcd = L & 7, j = L >> 3; u.pm = xcd * 4 + (j & 3); u.pn = j >> 2; } u.w = i & 1; u.pad = 0;
        u.a = (u.w ? A1 : A0) + (size_t)u.pm * 256 * (DM * 2); u.b = (u.w ? B1 : B0) + (size_t)u.pn * 256 * (KD * 2); return true;
    }
};
struct EpiD {
    static constexpr bool PERM = true;
    const bf16_t* proj; bf16_t* mrg; const float* ssq;
    __device__ __forceinline__ bool operator()(f32x4 (&acc)[2][2][4][2], const Unit& u, int wr, int wc, int fr, int fq) const {
        const int row0 = u.pm * 256 + wr * 64 + fr, col0 = u.pn * 256 + wc * 32 + 8 * fq;
#pragma unroll
        for (int ai = 0; ai < 2; ++ai)
#pragma unroll
            for (int m = 0; m < 4; ++m) { const int row = row0 + ai * 128 + m * 16;
                float rs = 1.f;
                if (u.w == 0) { const f32x4 q = *(const f32x4*)(ssq + (size_t)row * 4); rs = rsqrtf(((q.x + q.y) + (q.z + q.w)) * (1.f / 2048.f) + EPS); }
#pragma unroll
                for (int bj = 0; bj < 2; ++bj) { const int col = col0 + bj * 128;
                    const u32x4 gm = *(const u32x4*)(proj + pjf(row, C_GM + col));
                    float eb[8] = {bflo(gm.x), bfhi(gm.x), bflo(gm.y), bfhi(gm.y), bflo(gm.z), bfhi(gm.z), bflo(gm.w), bfhi(gm.w)};
#pragma unroll
                    for (int e = 0; e < 8; ++e) eb[e] = 1.f + __expf(-fmaxf(eb[e], -30.f));
                    if (u.w == 0) {
                        const u32x4 gs = *(const u32x4*)(proj + pjf(row, C_GS + col));
                        float ea[8] = {bflo(gs.x), bfhi(gs.x), bflo(gs.y), bfhi(gs.y), bflo(gs.z), bfhi(gs.z), bflo(gs.w), bfhi(gs.w)};
#pragma unroll
                        for (int e = 0; e < 8; ++e) ea[e] = rs * eb[e] * __builtin_amdgcn_rcpf(1.f + __expf(-ea[e]));
                        acc[ai][bj][m][0] *= (f32x4){ea[0], ea[1], ea[2], ea[3]}; acc[ai][bj][m][1] *= (f32x4){ea[4], ea[5], ea[6], ea[7]};
                    } else {
#pragma unroll
                        for (int e = 0; e < 8; ++e) eb[e] = __builtin_amdgcn_rcpf(eb[e]);
                        const f32x4 v0 = acc[ai][bj][m][0] * (f32x4){eb[0], eb[1], eb[2], eb[3]}, v1 = acc[ai][bj][m][1] * (f32x4){eb[4], eb[5], eb[6], eb[7]};
                        u32x4 w; w.x = pk2(v0[0], v0[1]); w.y = pk2(v0[2], v0[3]); w.z = pk2(v1[0], v1[1]); w.w = pk2(v1[2], v1[3]);
                        *(u32x4*)(mrg + (size_t)row * DM + col) = w; } } }
        return u.w != 0;
    }
};
struct SchedE {
    int G, c; const char* A; const char* B;
    __device__ __forceinline__ bool next(int i, Unit& u) const {
        const int L = i * G + c; if (L >= 256) return false;
        { const int xcd = L & 7, j = L >> 3; u.pm = xcd * 4 + (j & 3); u.pn = j >> 2; } u.w = 0; u.pad = 0;
        u.a = A + (size_t)u.pm * 256 * (DM * 2); u.b = B + (size_t)u.pn * 256 * (KD * 2); return true;
    }
};
__device__ __forceinline__ void panel_wait(unsigned* cnt, unsigned need) {
    xb_add(cnt, 1u);
    unsigned sp = 0u;
    while (xb_ld(cnt) < need) { __builtin_amdgcn_s_sleep(1); if (++sp > (1u << 22)) break; }
}
struct EpiE {
    static constexpr bool PERM = false;
    const float* xp; const float* xs; const float* mods; const float* gfin; float* out; float* rss; unsigned* cnt; LAS unsigned char* lds;
    __device__ __forceinline__ bool operator()(f32x4 (&acc)[2][2][4][2], const Unit& u, int wr, int wc, int fr, int fq) const {
        const int tid = threadIdx.x;
        LAS float* part = (LAS float*)(lds + 131072);
        LAS float* rst = (LAS float*)(lds + 131072 + 4096);
        const int row0 = u.pm * 256 + wr * 64 + fr, col0 = u.pn * 256 + wc * 32 + 4 * fq;
        const float* gt = mods + stream_of(u.pm * 256) * 6144 + 4096;
        f32x4 gv[2][2];
#pragma unroll
        for (int bj = 0; bj < 2; ++bj)
#pragma unroll
            for (int n = 0; n < 2; ++n) gv[bj][n] = *(const f32x4*)(gt + col0 + bj * 128 + n * 16);
#pragma unroll
        for (int ai = 0; ai < 2; ++ai)
#pragma unroll
            for (int m = 0; m < 4; ++m) { const int row = row0 + ai * 128 + m * 16;
                const float* xr = row < TP ? xp + (size_t)row * DM : xs + (size_t)(row - TP) * DM;
                float ss = 0.f;
#pragma unroll
                for (int bj = 0; bj < 2; ++bj)
#pragma unroll
                    for (int n = 0; n < 2; ++n) { const int col = col0 + bj * 128 + n * 16;
                        const f32x4 o = *(const f32x4*)(xr + col) + gv[bj][n] * acc[ai][bj][m][n];
                        ss += (o.x * o.x + o.y * o.y) + (o.z * o.z + o.w * o.w);
                        acc[ai][bj][m][n] = o; }
                ss += __shfl_xor(ss, 16); ss += __shfl_xor(ss, 32);
                if (fq == 0) part[(ai * 128 + wr * 64 + m * 16 + fr) * 4 + wc] = ss; }
        __syncthreads();
        if (tid < 256) { const float v = (part[tid * 4] + part[tid * 4 + 1]) + (part[tid * 4 + 2] + part[tid * 4 + 3]);
            __hip_atomic_store(rss + (size_t)(u.pm * 256 + tid) * 32 + u.pn, v, __ATOMIC_RELAXED, __HIP_MEMORY_SCOPE_AGENT); }
        asm volatile("s_waitcnt vmcnt(0)" ::: "memory");
        __syncthreads();
        if (tid == 0) panel_wait(cnt + 64 * u.pm, 8u);
        __syncthreads();
        if (tid < 256) { float v = 0.f;
#pragma unroll
            for (int q = 0; q < 8; ++q) v += __hip_atomic_load(rss + (size_t)(u.pm * 256 + tid) * 32 + q, __ATOMIC_RELAXED, __HIP_MEMORY_SCOPE_AGENT);
            rst[tid] = rsqrtf(v * (1.f / DM) + EPS); }
        __syncthreads();
#pragma unroll
        for (int bj = 0; bj < 2; ++bj)
#pragma unroll
            for (int n = 0; n < 2; ++n) gv[bj][n] = *(const f32x4*)(gfin + col0 + bj * 128 + n * 16);
#pragma unroll
        for (int ai = 0; ai < 2; ++ai)
#pragma unroll
            for (int m = 0; m < 4; ++m) { const int rl = ai * 128 + wr * 64 + m * 16 + fr; const float r = rst[rl];
                float* op = out + (size_t)(u.pm * 256 + rl) * DM;
#pragma unroll
                for (int bj = 0; bj < 2; ++bj)
#pragma unroll
                    for (int n = 0; n < 2; ++n) { const int col = col0 + bj * 128 + n * 16; *(f32x4*)(op + col) = acc[ai][bj][m][n] * r * gv[bj][n]; } }
        return true;
    }
};
__device__ __forceinline__ f32x4 small_gemm(LAS unsigned char* lds, const bf16_t* As  , int rl0, const bf16_t* Wf  , int n0) {
    const int tid = threadIdx.x, lane = tid & 63, wave = __builtin_amdgcn_readfirstlane(tid >> 6), fr = lane & 15, fq = lane >> 4;
    f32x4 acc[2][4];
#pragma unroll
    for (int rt = 0; rt < 2; ++rt)
#pragma unroll
        for (int ct = 0; ct < 4; ++ct) acc[rt][ct] = (f32x4){0.f, 0.f, 0.f, 0.f};
    const bf16_t* ap = As + ((size_t)(wave * 32 + fq) * 256 + rl0 + fr) * 8; const bf16_t* bp = Wf + ((size_t)(wave * 32 + fq) * 2048 + n0 + fr) * 8;
    {
        bf16x8 af[2][8], bf[4][8];
#pragma unroll
        for (int ks = 0; ks < 8; ++ks) {
#pragma unroll
            for (int rt = 0; rt < 2; ++rt) af[rt][ks] = *(const bf16x8*)(ap + (size_t)ks * 4 * 256 * 8 + rt * 16 * 8);
#pragma unroll
            for (int ct = 0; ct < 4; ++ct) bf[ct][ks] = *(const bf16x8*)(bp + (size_t)ks * 4 * 2048 * 8 + ct * 16 * 8);
        }
        __builtin_amdgcn_sched_barrier(0);
#pragma unroll
        for (int ks = 0; ks < 8; ++ks)
#pragma unroll
            for (int rt = 0; rt < 2; ++rt)
#pragma unroll
                for (int ct = 0; ct < 4; ++ct) acc[rt][ct] = mma16(bf[ct][ks], af[rt][ks], acc[rt][ct]);
    }
#pragma unroll
    for (int rt = 0; rt < 2; ++rt)
#pragma unroll
        for (int ct = 0; ct < 4; ++ct) *(LAS f32x4*)(lds + ((wave * 8 + rt * 4 + ct) * 64 + lane) * 16) = acc[rt][ct];
    __syncthreads();
    f32x4 v = (f32x4){0.f, 0.f, 0.f, 0.f};
#pragma unroll
    for (int w = 0; w < 8; ++w) v += *(const LAS f32x4*)(lds + ((w * 8 + (tid >> 6)) * 64 + lane) * 16);
    __syncthreads();
    return v;
}
__device__ __forceinline__ void sample_merge(const Params& P, LAS unsigned char* lds) {
    const int tid = threadIdx.x, l = tid & 63, tile = tid >> 6, rt = tile >> 2, ct = tile & 3;
    const bf16_t* proj = (const bf16_t*)(P.ws + WS_PROJ);
    const bf16_t* AS = (const bf16_t*)(P.ws + WS_AS); const bf16_t* WF = (const bf16_t*)(P.ws + WS_WF); bf16_t* mrgs = (bf16_t*)(P.ws + WS_AS) + (size_t)2 * 256 * 256 * 8;
    const float* ssq = (const float*)(P.ws + WS_SSQ);
    for (int b = blockIdx.x; b < 256; b += gridDim.x) {
        const int r0 = TP + (b >> 5) * 32, n0 = (b & 31) * 64;
        const f32x4 v1 = small_gemm(lds, AS, r0 - TP, WF, n0);
        const f32x4 v2 = small_gemm(lds, AS + (size_t)256 * 256 * 8, r0 - TP, WF + (size_t)2048 * 2048, n0);
        const int row = r0 + rt * 16 + (l & 15), col = n0 + ct * 16 + (l >> 4) * 4;
        const f32x4 q = *(const f32x4*)(ssq + (size_t)row * 4); const float rs = rsqrtf(((q.x + q.y) + (q.z + q.w)) * (1.f / 2048.f) + EPS);
        const u32x2 gs = *(const u32x2*)(proj + pjf(row, C_GS + col)), gm = *(const u32x2*)(proj + pjf(row, C_GM + col));
        const float m0 = sigm_f(bflo(gs.x)) * rs * v1[0] + sigm_f(bflo(gm.x)) * v2[0], m1 = sigm_f(bfhi(gs.x)) * rs * v1[1] + sigm_f(bfhi(gm.x)) * v2[1];
        const float m2 = sigm_f(bflo(gs.y)) * rs * v1[2] + sigm_f(bflo(gm.y)) * v2[2], m3 = sigm_f(bfhi(gs.y)) * rs * v1[3] + sigm_f(bfhi(gm.y)) * v2[3];
        u32x2 o; o.x = pk2(m0, m1); o.y = pk2(m2, m3); *(u32x2*)(mrgs + pjs(row - TP, col)) = o;
    }
}
__device__ __forceinline__ void sample_out(const Params& P, LAS unsigned char* lds) {
    const int tid = threadIdx.x, l = tid & 63, tile = tid >> 6, rt = tile >> 2, ct = tile & 3;
    const bf16_t* Wof = (const bf16_t*)(P.ws + WS_WF) + (size_t)2 * 2048 * 2048; const bf16_t* mrgs = (const bf16_t*)(P.ws + WS_AS) + (size_t)2 * 256 * 256 * 8;
    const float* mods = (const float*)(P.ws + WS_MODS); float* rss = (float*)(P.ws + WS_RSS); unsigned* cnt = (unsigned*)(P.ws + WS_CNT);
    LAS float* rsum = (LAS float*)(lds + 65536);
    LAS float* rst = (LAS float*)(lds + 65536 + 512);
    for (int b = blockIdx.x; b < 256; b += gridDim.x) {
        const int sb = b >> 5, cb = b & 31, r0 = TP + sb * 32, n0 = cb * 64;
        const f32x4 v = small_gemm(lds, mrgs, r0 - TP, Wof, n0);
        const int m = rt * 16 + (l & 15), row = r0 + m, col = n0 + ct * 16 + (l >> 4) * 4;
        const f32x4 o = *(const f32x4*)(P.in[1] + (size_t)(row - TP) * DM + col) + *(const f32x4*)(mods + (2 + sb) * 6144 + 4096 + col) * v;
        float ss = (o.x * o.x + o.y * o.y) + (o.z * o.z + o.w * o.w);
        ss += __shfl_xor(ss, 16); ss += __shfl_xor(ss, 32);
        if ((l >> 4) == 0) rsum[m * 4 + ct] = ss;
        __syncthreads();
        if (tid < 32) __hip_atomic_store(rss + (size_t)(r0 + tid) * 32 + cb, (rsum[tid * 4] + rsum[tid * 4 + 1]) + (rsum[tid * 4 + 2] + rsum[tid * 4 + 3]), __ATOMIC_RELAXED, __HIP_MEMORY_SCOPE_AGENT);
        asm volatile("s_waitcnt vmcnt(0)" ::: "memory");
        __syncthreads();
        if (tid == 0) panel_wait(cnt + 64 * (32 + sb), 32u * (unsigned)((b - blockIdx.x) / gridDim.x + 1));
        __syncthreads();
        if (tid < 32) { float t = 0.f;
            for (int q = 0; q < 32; ++q) t += __hip_atomic_load(rss + (size_t)(r0 + tid) * 32 + q, __ATOMIC_RELAXED, __HIP_MEMORY_SCOPE_AGENT);
            rst[tid] = rsqrtf(t * (1.f / DM) + EPS); }
        __syncthreads();
        *(f32x4*)(P.out + (size_t)row * DM + col) = o * rst[m] * *(const f32x4*)(P.in[23] + col);
        __syncthreads();
    }
}
__device__ __forceinline__ void phase8(const Params& P) {
    const int tid = threadIdx.x, lane = tid & 63, wave = tid >> 6;
    const int gw = blockIdx.x * 8 + wave, NGW = gridDim.x * 8;
    const float* rss = (const float*)(P.ws + WS_RSS);
    for (int r = gw; r < T; r += NGW) {
        float s = lane < 32 ? rss[(size_t)r * 32 + lane] : 0.f;
        s = wave_sum(s);
        const float rstd = rsqrtf(s * (1.f / DM) + EPS);
        f32x4* op = (f32x4*)(P.out + (size_t)r * DM);
#pragma unroll
        for (int j = 0; j < 8; ++j) { const f32x4 g = *(const f32x4*)(P.in[23] + (lane + 64 * j) * 4); op[lane + 64 * j] = op[lane + 64 * j] * rstd * g; }
    }
}

__global__ __launch_bounds__(512, 2) void mega(Params P) {
    extern __shared__ __attribute__((aligned(16))) unsigned char smem[];
    LAS unsigned char* lds = (LAS unsigned char*)smem;
    const unsigned ldsaddr = (unsigned)(uintptr_t)smem;
    cg::grid_group grid = cg::this_grid();
    const int lo = P.ph_lo, hi = P.ph_hi;
    if (hi > 1000) grid.sync();
    volatile LAS unsigned* xst = (volatile LAS unsigned*)(lds + LDS_BYTES - 16);
    if (threadIdx.x == 0) { xst[0] = 0u; xst[1] = 0u; }
    __syncthreads();
    const XcdBarrier xb = xcd_barrier_post((unsigned*)(P.ws + WS_BAR), xst);
#define SEAM(k) if (lo < (k) && (k) < hi) xcd_barrier(xb)
#define REP(k) for (int rep_ = 0; rep_ < ((k) == DUPK ? 2 : 1); ++rep_, (((k) == DUPK && rep_ == 1) ? xcd_barrier(xb) : (void)0))
    if (lo <= 0 && 0 < hi) REP(0) phase0(P, lds);
    if (lo <= 1 && 1 < hi) REP(1) phase1(P);
    SEAM(2);
    if (lo <= 2 && 2 < hi) REP(2) {
        SchedIn S; S.nM = 33; S.nN = 61; S.nwg = 33 * 61; S.G = gridDim.x; S.c = blockIdx.x; S.A = (const char*)(P.ws + WS_H); S.B = (const char*)(P.ws + WS_WIN);
        EpiIn E; E.proj = (bf16_t*)(P.ws + WS_PROJ); E.dt = (float*)(P.ws + WS_DT); E.dt_bias = P.in[12];
        pg8::gemm_phase(lds, KD, KD * 2, S, E);
#if DUPK == 21
        xcd_barrier(xb);
        pg8::gemm_phase<false>(lds, KD, KD * 2, S, E);
#endif
    }
    SEAM(3);
    if (lo <= 3 && 3 < hi) REP(3) phase3(P, lds, ldsaddr);
    SEAM(4);
    if (lo <= 4 && 4 < hi) { phase4(P, lds, ldsaddr); phase4b(P, lds); }
    SEAM(5);
#if DUPK == 50
    xcd_barrier(xb); xcd_barrier(xb); xcd_barrier(xb); xcd_barrier(xb);
#endif
    if (lo <= 5 && 5 < hi) REP(5) phase5(P, lds);
    SEAM(6);
    if (lo <= 6 && 6 < hi) REP(6) {
        SchedD S; S.G = gridDim.x; S.c = blockIdx.x; S.A0 = (const char*)(P.ws + WS_YZ); S.A1 = (const char*)(P.ws + WS_YMLP);
        S.B0 = (const char*)(P.ws + WS_WB); S.B1 = (const char*)(P.ws + WS_WB) + (size_t)2048 * 2048 * 2;
        EpiD E; E.proj = (const bf16_t*)(P.ws + WS_PROJ); E.mrg = (bf16_t*)(P.ws + WS_MRG); E.ssq = (const float*)(P.ws + WS_SSQ);
        pg8::gemm_phase(lds, KD, DM * 2, S, E);
        sample_merge(P, lds);
#if DUPK == 60
        sample_merge(P, lds);
#endif
    }
    SEAM(7);
    if (lo <= 7 && 7 < hi) REP(7) {
        SchedE S; S.G = gridDim.x; S.c = blockIdx.x; S.A = (const char*)(P.ws + WS_MRG); S.B = (const char*)(P.ws + WS_WB) + (size_t)2 * 2048 * 2048 * 2;
        EpiE E; E.xp = P.in[0]; E.xs = P.in[1]; E.mods = (const float*)(P.ws + WS_MODS); E.gfin = P.in[23]; E.out = P.out; E.rss = (float*)(P.ws + WS_RSS); E.cnt = (unsigned*)(P.ws + WS_CNT); E.lds = lds;
        pg8::gemm_phase(lds, KD, DM * 2, S, E);
        sample_out(P, lds);
    }
#undef SEAM
}

#ifndef N_LAUNCH_PER_PHASE
#define N_LAUNCH_PER_PHASE 0
#endif
extern "C" void kernel_launch(void* const* d_in, const int* in_sizes, int n_in, void* d_out, int out_size, void* d_ws, size_t ws_size, hipStream_t stream) {
    static int grid = 0;
    if (grid == 0) {
        if (n_in != 24 || ws_size < WS_END) { fprintf(stderr, "kernel_launch: unexpected n_in %d / ws_size %zu\n", n_in, ws_size); grid = -1; return; }
        int dev = 0, cus = 0, per_cu = 0;
        hipGetDevice(&dev); hipDeviceGetAttribute(&cus, hipDeviceAttributeMultiprocessorCount, dev);
        if (hipFuncSetAttribute((const void*)mega, hipFuncAttributeMaxDynamicSharedMemorySize, LDS_BYTES) != hipSuccess) { fprintf(stderr, "kernel_launch: hipFuncSetAttribute failed\n"); grid = -1; return; }
        if (hipOccupancyMaxActiveBlocksPerMultiprocessor(&per_cu, (const void*)mega, 512, LDS_BYTES) != hipSuccess || per_cu < 1) { fprintf(stderr, "kernel_launch: occupancy query gave %d\n", per_cu); per_cu = 1; }
        (void)hipGetLastError();
        grid = cus;
        fprintf(stderr, "kernel_launch: cus %d per_cu %d grid %d\n", cus, per_cu, grid);
    }
    if (grid < 0) return;
    if (hipMemsetAsync((char*)d_ws + WS_BAR, 0, 32768, stream) != hipSuccess) { fprintf(stderr, "kernel_launch: memset failed\n"); return; }
    Params p{};
    for (int i = 0; i < 24; ++i) p.in[i] = (const float*)d_in[i];
    p.out = (float*)d_out; p.ws = (unsigned char*)d_ws;
#if N_LAUNCH_PER_PHASE
    for (int ph = 0; ph < 8; ++ph) { p.ph_lo = ph; p.ph_hi = ph + 1; hipLaunchKernelGGL(mega, dim3(grid), dim3(512), LDS_BYTES, stream, p); }
#else
    p.ph_lo = 0; p.ph_hi = 8;
    void* args[] = {&p};
    hipError_t e = hipLaunchCooperativeKernel((const void*)mega, dim3(grid), dim3(512), args, LDS_BYTES, stream);
    if (e != hipSuccess) fprintf(stderr, "cooperative launch failed: %s (grid %d)\n", hipGetErrorString(e), grid);
#endif
}
```

```cpp
#include <hip/hip_runtime.h>
#include <hip/hip_cooperative_groups.h>
#include <cstdio>
#include <cstdint>
namespace cg = cooperative_groups;
#ifndef DUPK
#define DUPK -1
#endif

#define LAS __attribute__((address_space(3)))
typedef unsigned short bf16_t;
typedef short bf16x8 __attribute__((ext_vector_type(8)));
typedef float f32x4 __attribute__((ext_vector_type(4)));
typedef unsigned u32x4 __attribute__((ext_vector_type(4)));
typedef unsigned u32x2 __attribute__((ext_vector_type(2)));

constexpr int T = 8448, TP = 8192, DM = 2048, NPJ = 15360, NBT = 15616, KD = 2048;
constexpr int C_ZS = 0, C_XS = 2048, C_U = 5120, C_V = 7168, C_ZM = 9216, C_GS = 11264, C_GM = 13312;
constexpr float EPS = 1e-5f;
constexpr int LDS_BYTES = 139264;

constexpr size_t WS_WIN = 0;
constexpr size_t WS_H = 63963136;
constexpr size_t WS_S = 0;
constexpr size_t WS_PART = 0;
constexpr size_t WS_WB = 98566144;
constexpr size_t WS_PROJ = 123731968;
constexpr size_t WS_WF = 464821248;
constexpr size_t WS_AS = WS_WF + 3 * 8388608;
constexpr size_t WS_DT = 383254528;
constexpr size_t WS_EAC = 384335872;
constexpr size_t WS_YP = 385417216;
constexpr size_t WS_CPOST = 71303168;
constexpr size_t WS_MODS = 428670976;
constexpr size_t WS_BDEC = 428916736;
constexpr size_t WS_LNS = 428934144;
constexpr size_t WS_SSQ = 429001728;
constexpr size_t WS_RSS = 429136896;
constexpr size_t WS_YZ = 430218240;
constexpr size_t WS_YMLP = WS_PROJ + 34603008;
constexpr size_t WS_MRG = WS_YP;
constexpr size_t WS_BAR = 499424256;
constexpr size_t WS_CNT = WS_BAR + 16384;
constexpr size_t WS_END = 499424256 + 32768;

constexpr size_t O_Y = 0, O_SSMP = 17301504, O_CONVP = 17825792, O_SSMS = 17844224, O_CONVS = 19941376, O_VS = 20015104;

struct Params { const float* in[24]; float* out; unsigned char* ws; int ph_lo, ph_hi; };

typedef __bf16 bf16x2_t __attribute__((ext_vector_type(2)));
__device__ __forceinline__ unsigned pk2(float lo, float hi) { bf16x2_t v; v.x = (__bf16)lo; v.y = (__bf16)hi; return __builtin_bit_cast(unsigned, v); }
__device__ __forceinline__ float bflo(unsigned u) { return __uint_as_float(u << 16); }
__device__ __forceinline__ float bfhi(unsigned u) { return __uint_as_float(u & 0xffff0000u); }
__device__ __forceinline__ float silu_f(float x) { return x * __builtin_amdgcn_rcpf(1.f + __expf(-x)); }
__device__ __forceinline__ float sigm_f(float x) { return __builtin_amdgcn_rcpf(1.f + __expf(-x)); }
__device__ __forceinline__ float wave_sum(float v) {
#pragma unroll
    for (int o = 1; o < 64; o <<= 1) v += __shfl_xor(v, o);
    return v;
}
__device__ __forceinline__ f32x4 mma16(bf16x8 a, bf16x8 b, f32x4 c) { return __builtin_amdgcn_mfma_f32_16x16x32_bf16(a, b, c, 0, 0, 0); }
__device__ __forceinline__ bf16x8 rowfrag(const LAS unsigned char* base, int r0, int stride, int k0, int fr, int fq) {
    return *(const LAS bf16x8*)(base + (r0 + fr) * stride + (k0 + fq * 8) * 2);
}
__device__ __forceinline__ bf16x8 trfrag(unsigned base_addr, int k0, int n0, int stride, int lane) {
    const int g = lane >> 4, q = (lane & 15) >> 2, p = lane & 3;
    const unsigned a0 = base_addr + (unsigned)((k0 + 8 * g + q) * stride + (n0 + 4 * p) * 2);
    const unsigned a1 = a0 + 4u * (unsigned)stride;
    u32x2 r0, r1;
    asm volatile("ds_read_b64_tr_b16 %0, %2\n\tds_read_b64_tr_b16 %1, %3\n\ts_waitcnt lgkmcnt(0)" : "=&v"(r0), "=&v"(r1) : "v"(a0), "v"(a1) : "memory");
    u32x4 r; r.x = r0.x; r.y = r0.y; r.z = r1.x; r.w = r1.y;
    return __builtin_bit_cast(bf16x8, r);
}
__device__ __forceinline__ void tr8_xc(unsigned base_addr, int lane, bf16x8 (&out)[4][2]) {
    const int g = lane >> 4, q = (lane & 15) >> 2, p = lane & 3;
    const unsigned a0 = base_addr + (unsigned)((8 * g + q) * 1040 + 8 * p);
    u32x2 r[16];
    asm volatile("ds_read_b64_tr_b16 %0, %8 offset:0\n\t"
        "ds_read_b64_tr_b16 %1, %8 offset:4160\n\t"
        "ds_read_b64_tr_b16 %2, %8 offset:33280\n\t"
        "ds_read_b64_tr_b16 %3, %8 offset:37440\n\t"
        "ds_read_b64_tr_b16 %4, %8 offset:32\n\t"
        "ds_read_b64_tr_b16 %5, %8 offset:4192\n\t"
        "ds_read_b64_tr_b16 %6, %8 offset:33312\n\t"
        "ds_read_b64_tr_b16 %7, %8 offset:37472\n\t"
        "s_waitcnt lgkmcnt(0)" : "=&v"(r[0]), "=&v"(r[1]), "=&v"(r[2]), "=&v"(r[3]), "=&v"(r[4]), "=&v"(r[5]), "=&v"(r[6]), "=&v"(r[7]) : "v"(a0) : "memory");
    asm volatile("ds_read_b64_tr_b16 %0, %8 offset:64\n\t"
        "ds_read_b64_tr_b16 %1, %8 offset:4224\n\t"
        "ds_read_b64_tr_b16 %2, %8 offset:33344\n\t"
        "ds_read_b64_tr_b16 %3, %8 offset:37504\n\t"
        "ds_read_b64_tr_b16 %4, %8 offset:96\n\t"
        "ds_read_b64_tr_b16 %5, %8 offset:4256\n\t"
        "ds_read_b64_tr_b16 %6, %8 offset:33376\n\t"
        "ds_read_b64_tr_b16 %7, %8 offset:37536\n\t"
        "s_waitcnt lgkmcnt(0)" : "=&v"(r[8]), "=&v"(r[9]), "=&v"(r[10]), "=&v"(r[11]), "=&v"(r[12]), "=&v"(r[13]), "=&v"(r[14]), "=&v"(r[15]) : "v"(a0) : "memory");
#pragma unroll
    for (int a = 0; a < 4; ++a)
#pragma unroll
        for (int ks = 0; ks < 2; ++ks) { u32x4 v; v.x = r[(a * 2 + ks) * 2].x; v.y = r[(a * 2 + ks) * 2].y; v.z = r[(a * 2 + ks) * 2 + 1].x; v.w = r[(a * 2 + ks) * 2 + 1].y; out[a][ks] = __builtin_bit_cast(bf16x8, v); }
}
__device__ __forceinline__ void tr8_bm(unsigned base_addr, int lane, bf16x8 (&out)[4][2]) {
    const int g = lane >> 4, q = (lane & 15) >> 2, p = lane & 3;
    const unsigned a0 = base_addr + (unsigned)((8 * g + q) * 272 + 8 * p);
    u32x2 r[16];
    asm volatile("ds_read_b64_tr_b16 %0, %8 offset:0\n\t"
        "ds_read_b64_tr_b16 %1, %8 offset:1088\n\t"
        "ds_read_b64_tr_b16 %2, %8 offset:8704\n\t"
        "ds_read_b64_tr_b16 %3, %8 offset:9792\n\t"
        "ds_read_b64_tr_b16 %4, %8 offset:32\n\t"
        "ds_read_b64_tr_b16 %5, %8 offset:1120\n\t"
        "ds_read_b64_tr_b16 %6, %8 offset:8736\n\t"
        "ds_read_b64_tr_b16 %7, %8 offset:9824\n\t"
        "s_waitcnt lgkmcnt(0)" : "=&v"(r[0]), "=&v"(r[1]), "=&v"(r[2]), "=&v"(r[3]), "=&v"(r[4]), "=&v"(r[5]), "=&v"(r[6]), "=&v"(r[7]) : "v"(a0) : "memory");
    asm volatile("ds_read_b64_tr_b16 %0, %8 offset:64\n\t"
        "ds_read_b64_tr_b16 %1, %8 offset:1152\n\t"
        "ds_read_b64_tr_b16 %2, %8 offset:8768\n\t"
        "ds_read_b64_tr_b16 %3, %8 offset:9856\n\t"
        "ds_read_b64_tr_b16 %4, %8 offset:96\n\t"
        "ds_read_b64_tr_b16 %5, %8 offset:1184\n\t"
        "ds_read_b64_tr_b16 %6, %8 offset:8800\n\t"
        "ds_read_b64_tr_b16 %7, %8 offset:9888\n\t"
        "s_waitcnt lgkmcnt(0)" : "=&v"(r[8]), "=&v"(r[9]), "=&v"(r[10]), "=&v"(r[11]), "=&v"(r[12]), "=&v"(r[13]), "=&v"(r[14]), "=&v"(r[15]) : "v"(a0) : "memory");
#pragma unroll
    for (int a = 0; a < 4; ++a)
#pragma unroll
        for (int ks = 0; ks < 2; ++ks) { u32x4 v; v.x = r[(a * 2 + ks) * 2].x; v.y = r[(a * 2 + ks) * 2].y; v.z = r[(a * 2 + ks) * 2 + 1].x; v.w = r[(a * 2 + ks) * 2 + 1].y; out[a][ks] = __builtin_bit_cast(bf16x8, v); }
}
__device__ __forceinline__ void tr8_vn(unsigned base_addr, int lane, bf16x8 (&out)[8]) {
    const int g = lane >> 4, q = (lane & 15) >> 2, p = lane & 3;
    const unsigned a0 = base_addr + (unsigned)((8 * g + q) * 528 + 8 * p);
    u32x2 r[16];
    asm volatile("ds_read_b64_tr_b16 %0, %16 offset:0\n\t"
        "ds_read_b64_tr_b16 %1, %16 offset:2112\n\t"
        "ds_read_b64_tr_b16 %2, %16 offset:32\n\t"
        "ds_read_b64_tr_b16 %3, %16 offset:2144\n\t"
        "ds_read_b64_tr_b16 %4, %16 offset:64\n\t"
        "ds_read_b64_tr_b16 %5, %16 offset:2176\n\t"
        "ds_read_b64_tr_b16 %6, %16 offset:96\n\t"
        "ds_read_b64_tr_b16 %7, %16 offset:2208\n\t"
        "ds_read_b64_tr_b16 %8, %16 offset:128\n\t"
        "ds_read_b64_tr_b16 %9, %16 offset:2240\n\t"
        "ds_read_b64_tr_b16 %10, %16 offset:160\n\t"
        "ds_read_b64_tr_b16 %11, %16 offset:2272\n\t"
        "ds_read_b64_tr_b16 %12, %16 offset:192\n\t"
        "ds_read_b64_tr_b16 %13, %16 offset:2304\n\t"
        "ds_read_b64_tr_b16 %14, %16 offset:224\n\t"
        "ds_read_b64_tr_b16 %15, %16 offset:2336\n\t"
        "s_waitcnt lgkmcnt(0)" : "=&v"(r[0]), "=&v"(r[1]), "=&v"(r[2]), "=&v"(r[3]), "=&v"(r[4]), "=&v"(r[5]), "=&v"(r[6]), "=&v"(r[7]), "=&v"(r[8]), "=&v"(r[9]), "=&v"(r[10]), "=&v"(r[11]), "=&v"(r[12]), "=&v"(r[13]), "=&v"(r[14]), "=&v"(r[15]) : "v"(a0) : "memory");
#pragma unroll
    for (int a = 0; a < 8; ++a) { u32x4 v; v.x = r[2 * a].x; v.y = r[2 * a].y; v.z = r[2 * a + 1].x; v.w = r[2 * a + 1].y; out[a] = __builtin_bit_cast(bf16x8, v); }
}
__device__ __forceinline__ u32x4 widen16(u32x2 A, u32x2 B) {
    const auto r0 = __builtin_amdgcn_permlane16_swap(A.x, B.x, false, false);
    const auto r1 = __builtin_amdgcn_permlane16_swap(A.y, B.y, false, false);
    u32x4 o; o.x = r0[0]; o.y = r1[0]; o.z = r0[1]; o.w = r1[1]; return o;
}
__device__ __forceinline__ void unwiden16(u32x4 w, u32x2& A, u32x2& B) {
    const auto r0 = __builtin_amdgcn_permlane16_swap(w.x, w.z, false, false);
    const auto r1 = __builtin_amdgcn_permlane16_swap(w.y, w.w, false, false);
    A.x = r0[0]; A.y = r1[0]; B.x = r0[1]; B.y = r1[1];
}
__device__ __forceinline__ bf16x8 pack8(const float* m) {
    u32x4 r; r.x = pk2(m[0], m[1]); r.y = pk2(m[2], m[3]); r.z = pk2(m[4], m[5]); r.w = pk2(m[6], m[7]);
    return __builtin_bit_cast(bf16x8, r);
}
__device__ __forceinline__ size_t pj(int row, int col) { return ((size_t)(col >> 8) * T + row) * 256 + (col & 255); }
__device__ __forceinline__ size_t pjf(int row, int col) { return ((size_t)(col >> 3) * T + row) * 8 + (col & 7); }
__device__ __forceinline__ bool pn_is_frag(int pn) { return !((pn >= 8 && pn < 20) || (pn >= 28 && pn < 36)); }
__device__ __forceinline__ size_t pjs(int rl, int col) { return ((size_t)(col >> 3) * 256 + rl) * 8 + (col & 7); }
__device__ __forceinline__ int stream_of(int r) { return r < TP ? (r >> 12) : 2 + ((r - TP) >> 5); }


#define XB_TMO      128
#define XB_XCNT(j)  (256  + 64 * (j))
#define XB_XSUB(j)  (1280 + 64 * (j))
#define XB_XGEN(j)  (2304 + 64 * (j))
#define XB_TOP      3328
#define XB_TOPGEN   3392
#define XCD_BAR_WORDS 3456
#define XB_SPIN_CAP (1u << 18)
__device__ __forceinline__ unsigned xb_ld(unsigned* p)              { return __hip_atomic_load(p, __ATOMIC_RELAXED, __HIP_MEMORY_SCOPE_AGENT); }
__device__ __forceinline__ unsigned xb_add(unsigned* p, unsigned v) { return __hip_atomic_fetch_add(p, v, __ATOMIC_RELAXED, __HIP_MEMORY_SCOPE_AGENT); }
__device__ __forceinline__ unsigned xb_xcc_id() { return (unsigned)__builtin_amdgcn_s_getreg((3 << 11) | 20) & 0xFu; }
#define XB_SPIN(cond, bar) do { unsigned _sp = 0; while (cond) { __builtin_amdgcn_s_sleep(1); \
    if ((++_sp & 255u) == 0u) { if (xb_ld(&(bar)[XB_TMO])) break; if (_sp > XB_SPIN_CAP) { atomicAdd(&(bar)[XB_TMO], 1u); break; } } } } while (0)
struct XcdBarrier { unsigned* bar; unsigned x; volatile LAS unsigned* st; };
__device__ __forceinline__ XcdBarrier xcd_barrier_post(unsigned* bar, volatile LAS unsigned* st) {
    XcdBarrier b; b.bar = bar; b.x = xb_xcc_id(); b.st = st;
    if (threadIdx.x == 0) (void)xb_add(&bar[XB_XCNT(b.x)], 1u);
    return b;
}
__device__ __forceinline__ void xcd_barrier_complete(unsigned* bar, unsigned x, unsigned& nloc, unsigned& nx) {
    const unsigned G = gridDim.x * gridDim.y * gridDim.z;
    unsigned sum, cnt, mine, sp = 0u;
    for (;;) {
        sum = 0u; cnt = 0u; mine = 0u;
#pragma unroll
        for (unsigned j = 0; j < 16; ++j) { const unsigned c = xb_ld(&bar[XB_XCNT(j)]); sum += c; cnt += (c > 0u) ? 1u : 0u; mine = (j == x) ? c : mine; }
        if (sum == G) break;
        __builtin_amdgcn_s_sleep(1);
        if ((++sp & 255u) == 0u) { if (xb_ld(&bar[XB_TMO])) break; if (sp > XB_SPIN_CAP) { atomicAdd(&bar[XB_TMO], 1u); break; } }
    }
    nloc = mine > 0u ? mine : 1u; nx = cnt > 0u ? cnt : 1u;
}
__device__ __forceinline__ void xcd_barrier(const XcdBarrier& b) {
    asm volatile("s_waitcnt vmcnt(0)" ::: "memory");
    __syncthreads();
    if (threadIdx.x == 0) {
        unsigned* bar = b.bar;
        __builtin_amdgcn_s_waitcnt(0);
        unsigned nloc = b.st[0], nx = b.st[1];
        if (nloc == 0u) { xcd_barrier_complete(bar, b.x, nloc, nx); b.st[0] = nloc; b.st[1] = nx; }
        const unsigned old = xb_add(&bar[XB_XSUB(b.x)], 1u);
        const unsigned gen = old / nloc;
        if (old + 1u == (gen + 1u) * nloc) {
            __builtin_amdgcn_fence(__ATOMIC_RELEASE, "agent");
            asm volatile("s_waitcnt vmcnt(0)" ::: "memory");
            const unsigned og = xb_add(&bar[XB_TOP], 1u);
            const unsigned tg = og / nx;
            if (og + 1u == (tg + 1u) * nx) xb_add(&bar[XB_TOPGEN], 1u);
            else XB_SPIN(xb_ld(&bar[XB_TOPGEN]) == tg, bar);
            __builtin_amdgcn_fence(__ATOMIC_ACQUIRE, "agent");
            xb_add(&bar[XB_XGEN(b.x)], 1u);
            asm volatile("s_waitcnt vmcnt(0)" ::: "memory");
        } else {
            XB_SPIN(xb_ld(&bar[XB_XGEN(b.x)]) == gen, bar);
            __builtin_amdgcn_fence(__ATOMIC_ACQUIRE, "agent");
            asm volatile("s_waitcnt vmcnt(0)" ::: "memory");
        }
    }
    __syncthreads();
}

namespace pg8 {
constexpr int BM = 256, BK = 64, HALF = 128, HTB = HALF * BK * 2, STAGE_BYTES = 8 * HTB, NXCD = 8, WGM = 8;
__host__ __device__ __forceinline__ int lds_byte(int r, int c) { const int st = (r >> 4) * 2 + (c >> 5), rr = r & 15, cc = c & 31, ob = rr * 64 + cc * 2; return st * 1024 + (ob ^ (((ob >> 9) & 1) << 5)); }
__host__ __device__ __forceinline__ void stage_rc(int b, int& R, int& C) { const int st = b / 1024, sb = b % 1024, swz = sb ^ (((sb >> 9) & 1) << 5); R = (st >> 1) * 16 + swz / 64; C = (st & 1) * 32 + (swz % 64) / 2; }
__host__ __device__ __forceinline__ int perm32(int rho) { const int n = rho >> 4, i = rho & 15; return 8 * (i >> 2) + 4 * n + (i & 3); }

struct Unit { int pm, pn, w, pad; const char* a; const char* b; };

template <bool DOEPI = true, class Epi, class Sched>
__device__ __forceinline__ void gemm_phase(LAS unsigned char* lds, const int K, const int lda  , const Sched& S, const Epi& E) {
    const int tid = threadIdx.x, wid = __builtin_amdgcn_readfirstlane(tid >> 6), lane = tid & 63, wr = wid >> 2, wc = wid & 3, fr = lane & 15, fq = lane >> 4;
    const int nt = K / BK;
    unsigned voffA[2], voffB[2];
#pragma unroll
    for (int i = 0; i < 2; ++i) { int R, C; stage_rc(tid * 16 + i * 8192, R, C); const int Rb = Epi::PERM ? ((R & ~31) + perm32(R & 31)) : R;
        voffA[i] = (unsigned)(R * lda + C * 2); voffB[i] = (unsigned)(Rb * K + C) * 2u; }
    const size_t kstep = (size_t)(BK * 2);
    const size_t hstepA = (size_t)HALF * lda, hstepB = (size_t)HALF * K * 2;
    const unsigned ldsw = (unsigned)wid * 1024u;
    const int aoff = lds_byte(wr * 64 + fr, fq * 8), boff = lds_byte(wc * 32 + fr, fq * 8);
#define PG8_SA(b, h) (((b) * 2 + (h)) * HTB)
#define PG8_SB(b, h) ((4 + (b) * 2 + (h)) * HTB)
#define PG8_STAGE(bufoff, gbase, voff) do { _Pragma("unroll") for (int _i = 0; _i < 2; ++_i) \
        __builtin_amdgcn_global_load_lds((const unsigned*)((const char*)(gbase) + (voff)[_i]), (LAS unsigned*)(lds + (bufoff) + ldsw + _i * 8192), 16, 0, 0); } while (0)
#define PG8_LDA(dst, b, h) do { _Pragma("unroll") for (int m = 0; m < 4; ++m) _Pragma("unroll") for (int k = 0; k < 2; ++k) dst[m][k] = *(const LAS bf16x8*)(lds + PG8_SA(b, h) + aoff + m * 2048 + k * 1024); } while (0)
#define PG8_LDB(dst, b, h) do { _Pragma("unroll") for (int n = 0; n < 2; ++n) _Pragma("unroll") for (int k = 0; k < 2; ++k) dst[n][k] = *(const LAS bf16x8*)(lds + PG8_SB(b, h) + boff + n * 2048 + k * 1024); } while (0)
#define PG8_MMA(ai, bj, At, Bt) do { __builtin_amdgcn_s_setprio(1); _Pragma("unroll") for (int m = 0; m < 4; ++m) _Pragma("unroll") for (int n = 0; n < 2; ++n) _Pragma("unroll") for (int k = 0; k < 2; ++k) \
        acc[ai][bj][m][n] = __builtin_amdgcn_mfma_f32_16x16x32_bf16(Bt[n][k], At[m][k], acc[ai][bj][m][n], 0, 0, 0); __builtin_amdgcn_s_setprio(0); } while (0)
#define PG8_WAIT_V(n) asm volatile("s_waitcnt vmcnt(" #n ")" ::: "memory")
#define PG8_WAIT_L(n) asm volatile("s_waitcnt lgkmcnt(" #n ")" ::: "memory")
#define PG8_BAR __builtin_amdgcn_s_barrier()
#define PG8_SCHED __builtin_amdgcn_sched_barrier(0)
    Unit cur, nxt; int ui = 0;
    if (!S.next(0, cur)) return;
    f32x4 acc[2][2][4][2];
#pragma unroll
    for (int a = 0; a < 2; ++a)
#pragma unroll
        for (int b = 0; b < 2; ++b)
#pragma unroll
            for (int m = 0; m < 4; ++m)
#pragma unroll
                for (int n = 0; n < 2; ++n) acc[a][b][m][n] = (f32x4){0.f, 0.f, 0.f, 0.f};
    bf16x8 At[4][2], B0[2][2], B1[2][2];
    const char* cA = cur.a; const char* cB = cur.b;
    PG8_STAGE(PG8_SB(0, 0), cB, voffB); PG8_STAGE(PG8_SB(0, 1), cB + hstepB, voffB); PG8_STAGE(PG8_SA(0, 0), cA, voffA); PG8_STAGE(PG8_SA(0, 1), cA + hstepA, voffA);
    if (wr == 1) PG8_BAR;
    PG8_WAIT_V(2); PG8_BAR;
    PG8_STAGE(PG8_SB(1, 0), cB + kstep, voffB); PG8_STAGE(PG8_SA(1, 0), cA + kstep, voffA); PG8_STAGE(PG8_SB(1, 1), cB + hstepB + kstep, voffB);
    PG8_WAIT_V(6); PG8_BAR;
    for (;;) {
        const bool has_next = S.next(ui + 1, nxt);
        const char* nA = has_next ? nxt.a : cA; const char* nB = has_next ? nxt.b : cB;
        for (int t = 0; t < nt; t += 2) {
            const bool last = (t == nt - 2);
            const char* a1 = cA + (size_t)(t + 1) * kstep;
            const char* a2 = last ? nA : cA + (size_t)(t + 2) * kstep; const char* b2 = last ? nB : cB + (size_t)(t + 2) * kstep;
            const char* a3 = a2 + kstep; const char* b3 = b2 + kstep;
            PG8_LDB(B0, 0, 0); PG8_LDB(B1, 0, 1); PG8_SCHED; PG8_LDA(At, 0, 0); PG8_STAGE(PG8_SA(1, 1), a1 + hstepA, voffA);
            PG8_WAIT_V(8); PG8_WAIT_L(0); PG8_BAR; PG8_MMA(0, 0, At, B0); PG8_MMA(0, 1, At, B1); PG8_BAR; PG8_SCHED;
            PG8_LDA(At, 0, 1); PG8_STAGE(PG8_SB(0, 0), b2, voffB); PG8_STAGE(PG8_SB(0, 1), b2 + hstepB, voffB); PG8_STAGE(PG8_SA(0, 0), a2, voffA);
            PG8_WAIT_V(8); PG8_WAIT_L(0); PG8_BAR; PG8_MMA(1, 0, At, B0); PG8_MMA(1, 1, At, B1); PG8_BAR; PG8_SCHED;
            PG8_LDB(B0, 1, 0); PG8_LDB(B1, 1, 1); PG8_SCHED; PG8_LDA(At, 1, 0); PG8_STAGE(PG8_SA(0, 1), a2 + hstepA, voffA);
            PG8_WAIT_V(8); PG8_WAIT_L(0); PG8_BAR; PG8_MMA(0, 0, At, B0); PG8_MMA(0, 1, At, B1); PG8_BAR; PG8_SCHED;
            PG8_LDA(At, 1, 1); PG8_STAGE(PG8_SB(1, 0), b3, voffB); PG8_STAGE(PG8_SB(1, 1), b3 + hstepB, voffB); PG8_STAGE(PG8_SA(1, 0), a3, voffA);
            PG8_WAIT_V(8); PG8_WAIT_L(0); PG8_BAR; PG8_MMA(1, 0, At, B0); PG8_MMA(1, 1, At, B1); PG8_BAR; PG8_SCHED;
        }
        if (wr == 0) PG8_BAR;
        bool zacc = true;
        if (DOEPI) zacc = E(acc, cur, wr, wc, fr, fq);
        else { f32x4 t = (f32x4){0.f, 0.f, 0.f, 0.f};
#pragma unroll
            for (int a = 0; a < 2; ++a)
#pragma unroll
                for (int b = 0; b < 2; ++b)
#pragma unroll
                    for (int m = 0; m < 4; ++m)
#pragma unroll
                        for (int n = 0; n < 2; ++n) t += acc[a][b][m][n];
            if (t.x + t.y + t.z + t.w == 123456.789f) *(volatile float*)cur.a = 0.f; }
        if (!has_next) break;
        if (zacc) {
#pragma unroll
        for (int a = 0; a < 2; ++a)
#pragma unroll
            for (int b = 0; b < 2; ++b)
#pragma unroll
                for (int m = 0; m < 4; ++m)
#pragma unroll
                    for (int n = 0; n < 2; ++n) acc[a][b][m][n] = (f32x4){0.f, 0.f, 0.f, 0.f};
        }
        cur = nxt; cA = nA; cB = nB; ++ui;
        if (wr == 1) PG8_BAR;
    }
    PG8_WAIT_V(0);
    PG8_BAR;
#undef PG8_SA
#undef PG8_SB
#undef PG8_STAGE
#undef PG8_LDA
#undef PG8_LDB
#undef PG8_MMA
#undef PG8_WAIT_V
#undef PG8_WAIT_L
#undef PG8_BAR
#undef PG8_SCHED
}
}
using pg8::Unit;

__device__ __forceinline__ void phase0(const Params& P, LAS unsigned char* lds) {
    const int tid = threadIdx.x, lane = tid & 63, wave = tid >> 6;
    float* mods = (float*)(P.ws + WS_MODS);
    if (blockIdx.x < 192) {
        LAS float* sc = (LAS float*)lds;
        LAS float* red = (LAS float*)(lds + 81920);
        for (int i = tid; i < 10 * 2048; i += 512) { const int s = i >> 11, k = i & 2047; const float c = s < 2 ? P.in[4][s * 2048 + k] : P.in[5][(s - 2) * 2048 + k]; sc[i] = silu_f(c); }
        __syncthreads();
        for (int cb = blockIdx.x; cb < 192; cb += gridDim.x) {
            const int cgp = tid & 7, ksl = tid >> 3, j = cb * 32 + cgp * 4;
            f32x4 acc[10];
#pragma unroll
            for (int s = 0; s < 10; ++s) acc[s] = (f32x4){0.f, 0.f, 0.f, 0.f};
            const float* w = P.in[6] + j;
#pragma unroll 8
            for (int i = 0; i < 32; ++i) { const int k = ksl + 64 * i; const f32x4 wv = __builtin_nontemporal_load((const f32x4*)(w + (size_t)k * 6144));
#pragma unroll
                for (int s = 0; s < 10; ++s) acc[s] += wv * sc[s * 2048 + k]; }
#pragma unroll
            for (int s = 0; s < 10; ++s)
#pragma unroll
                for (int e = 0; e < 4; ++e) { float v = acc[s][e]; v += __shfl_xor(v, 8); v += __shfl_xor(v, 16); v += __shfl_xor(v, 32); acc[s][e] = v; }
            if (lane < 8) {
#pragma unroll
                for (int s = 0; s < 10; ++s) *(LAS f32x4*)(red + (wave * 10 + s) * 32 + cgp * 4) = acc[s]; }
            __syncthreads();
            if (tid < 320) { const int s = tid >> 5, jj = tid & 31; float v = 0.f;
#pragma unroll
                for (int q = 0; q < 8; ++q) v += red[(q * 10 + s) * 32 + jj];
                mods[s * 6144 + cb * 32 + jj] = v + P.in[7][cb * 32 + jj]; }
            asm volatile("s_waitcnt vmcnt(0)" ::: "memory");
            __syncthreads();
            if (tid == 0) { __builtin_amdgcn_fence(__ATOMIC_RELEASE, "agent"); asm volatile("s_waitcnt vmcnt(0)" ::: "memory"); xb_add((unsigned*)(P.ws + WS_CNT) + 64 * 48, 1u); }
        }
    }
    __syncthreads();
    LAS float* scr = (LAS float*)(lds + wave * 8448);
    const int gw = blockIdx.x * 8 + wave, NGW = gridDim.x * 8;
    constexpr int I_IN = 32 * 488, I_SQ = 32 * 64, NIT = I_IN + 3 * I_SQ;
    bf16_t* Win = (bf16_t*)(P.ws + WS_WIN); bf16_t* Wb = (bf16_t*)(P.ws + WS_WB);
    struct TItem { const float* src; const float* ksc; bf16_t* dst; bf16_t* dstf; int ldw; int zero; };
    auto decode = [&](int it, TItem& t) {
        const float* W; int ldw, nbsrc, nbdst, kb; bf16_t* dst; const float* ksc = nullptr;
        if (it < I_IN) { kb = it / 488; nbdst = it % 488; nbsrc = nbdst < 160 ? nbdst : (nbdst < 480 ? nbdst + 1 : (nbdst == 480 ? 160 : -1)); W = P.in[9]; ldw = 15392; dst = Win; }
        else { int r = it - I_IN; const int m = r / I_SQ; r -= m * I_SQ; kb = r / 64; nbdst = r % 64; nbsrc = nbdst; ldw = 2048; W = m == 0 ? P.in[20] : (m == 1 ? P.in[21] : P.in[22]); dst = Wb + (size_t)m * 2048 * 2048; if (m == 0) ksc = P.in[15]; }
        t.zero = nbsrc < 0; t.ldw = ldw; t.ksc = ksc ? ksc + kb * 64 : nullptr;
        t.src = W + (size_t)(kb * 64) * ldw + (t.zero ? 0 : nbsrc * 32);
        t.dst = dst + (size_t)(nbdst * 32) * KD + kb * 64;
        t.dstf = it < I_IN ? nullptr : (bf16_t*)(P.ws + WS_WF) + (size_t)((it - I_IN) / I_SQ) * 2048 * 2048 + ((size_t)(kb * 8) * 2048 + nbdst * 32) * 8;
    };
    auto issue = [&](const TItem& t, f32x4 (&v)[8]) {
#pragma unroll
        for (int i = 0; i < 8; ++i) { const int kk = 8 * i + (lane >> 3), nn = (lane & 7) * 4; v[i] = __builtin_nontemporal_load((const f32x4*)(t.src + (size_t)kk * t.ldw + nn)); }
    };
    const int c8 = lane & 7;
    TItem cur; f32x4 v[8];
    int it = gw;
    if (it < NIT) { decode(it, cur); issue(cur, v); }
    while (it < NIT) {
        const int itn = it + NGW; TItem nxt = cur; f32x4 vn[8];
        if (itn < NIT) { decode(itn, nxt); issue(nxt, vn); }
        else {
#pragma unroll
            for (int i = 0; i < 8; ++i) vn[i] = (f32x4){0.f, 0.f, 0.f, 0.f}; }
#pragma unroll
        for (int i = 0; i < 8; ++i) { const int kk = 8 * i + (lane >> 3), nn = (lane & 7) * 4; f32x4 x = v[i]; if (cur.ksc) x = x * cur.ksc[kk]; if (cur.zero) x = (f32x4){0.f, 0.f, 0.f, 0.f};
            scr[kk * 33 + nn] = x.x; scr[kk * 33 + nn + 1] = x.y; scr[kk * 33 + nn + 2] = x.z; scr[kk * 33 + nn + 3] = x.w; }
        asm volatile("s_waitcnt lgkmcnt(0)" ::: "memory");
#pragma unroll
        for (int j = 0; j < 4; ++j) { const int n = (lane >> 3) + 8 * j; const LAS float* sp = scr + (8 * c8) * 33 + n;
            u32x4 o; o.x = pk2(sp[0 * 33], sp[1 * 33]); o.y = pk2(sp[2 * 33], sp[3 * 33]); o.z = pk2(sp[4 * 33], sp[5 * 33]); o.w = pk2(sp[6 * 33], sp[7 * 33]);
            *(u32x4*)(cur.dst + (size_t)n * KD + 8 * c8) = o;
            if (cur.dstf) *(u32x4*)(cur.dstf + ((size_t)c8 * 2048 + n) * 8) = o; }
        asm volatile("s_waitcnt lgkmcnt(0)" ::: "memory");
        cur = nxt; it = itn;
#pragma unroll
        for (int i = 0; i < 8; ++i) v[i] = vn[i];
    }
}

__device__ __forceinline__ void phase1(const Params& P) {
    const int tid = threadIdx.x, lane = tid & 63, wave = tid >> 6;
    if (tid == 0) { unsigned* c = (unsigned*)(P.ws + WS_CNT) + 64 * 48; unsigned sp = 0u;
        while (xb_ld(c) < 192u) { __builtin_amdgcn_s_sleep(1); if (++sp > (1u << 22)) break; }
        __builtin_amdgcn_fence(__ATOMIC_ACQUIRE, "agent"); asm volatile("s_waitcnt vmcnt(0)" ::: "memory"); }
    __syncthreads();
    const int gw = blockIdx.x * 8 + wave, NGW = gridDim.x * 8;
    const float* mods = (const float*)(P.ws + WS_MODS); bf16_t* H = (bf16_t*)(P.ws + WS_H);
    auto xrow = [&](int r) { return r < TP ? P.in[0] + (size_t)r * DM : P.in[1] + (size_t)(r - TP) * DM; };
    f32x4 v[8];
    if (gw < T) { const float* xr = xrow(gw);
#pragma unroll
        for (int j = 0; j < 8; ++j) v[j] = __builtin_nontemporal_load((const f32x4*)xr + 2 * lane + (j & 1) + 128 * (j >> 1)); }
    for (int r = gw; r < T; r += NGW) {
        const int s = stream_of(r);
        f32x4 vn[8];
        if (r + NGW < T) { const float* xn = xrow(r + NGW);
#pragma unroll
            for (int j = 0; j < 8; ++j) vn[j] = __builtin_nontemporal_load((const f32x4*)xn + 2 * lane + (j & 1) + 128 * (j >> 1)); }
        else {
#pragma unroll
            for (int j = 0; j < 8; ++j) vn[j] = (f32x4){0.f, 0.f, 0.f, 0.f}; }
        float ss = 0.f;
#pragma unroll
        for (int j = 0; j < 8; ++j) ss += (v[j].x * v[j].x + v[j].y * v[j].y) + (v[j].z * v[j].z + v[j].w * v[j].w);
        ss = wave_sum(ss);
        const float rstd = rsqrtf(ss * (1.f / DM) + EPS);
        const float* ms = mods + s * 6144;
#pragma unroll
        for (int jj = 0; jj < 4; ++jj) { u32x4 o;
#pragma unroll
            for (int k2 = 0; k2 < 2; ++k2) { const int j = 2 * jj + k2, col = (2 * lane + k2 + 128 * jj) * 4;
                const f32x4 g = *(const f32x4*)(P.in[8] + col), sh = *(const f32x4*)(ms + col), sl = *(const f32x4*)(ms + 2048 + col);
                const f32x4 h = v[j] * rstd * g * (sl + 1.f) + sh;
                if (k2 == 0) { o.x = pk2(h.x, h.y); o.y = pk2(h.z, h.w); } else { o.z = pk2(h.x, h.y); o.w = pk2(h.z, h.w); } }
            *(u32x4*)(H + (size_t)r * DM + (2 * lane + 128 * jj) * 4) = o; }
#pragma unroll
        for (int j = 0; j < 8; ++j) v[j] = vn[j];
    }
}

struct SchedIn {
    int nM, nN, nwg, G, c; const char* A; const char* B;
    __device__ __forceinline__ bool next(int i, Unit& u) const {
        const long L = (long)i * G + c; if (L >= nwg) return false;
        int wgid = (int)L; { const int q = nwg / 8, r = nwg % 8, xcd = wgid % 8, off = wgid / 8; wgid = (xcd < r ? xcd * (q + 1) : r * (q + 1) + (xcd - r) * q) + off; }
        const int nig = 8 * nN, gid = wgid / nig, fm = gid * 8, gsz = (nM - fm) < 8 ? (nM - fm) : 8;
        u.pm = fm + ((wgid % nig) % gsz); u.pn = (wgid % nig) / gsz; u.w = 0; u.pad = 0;
        u.a = A + (size_t)u.pm * 256 * (KD * 2); u.b = B + (size_t)u.pn * 256 * (KD * 2); return true;
    }
};
struct EpiIn {
    static constexpr bool PERM = true;
    bf16_t* proj; float* dt; const float* dt_bias;
    __device__ __forceinline__ bool operator()(const f32x4 (&acc)[2][2][4][2], const Unit& u, int wr, int wc, int fr, int fq) const {
        const int row0 = u.pm * 256 + wr * 64 + fr;
        if (u.pn < 60) {
            const int col0 = u.pn * 256 + wc * 32 + 8 * fq; const bool frag = pn_is_frag(u.pn);
#pragma unroll
            for (int ai = 0; ai < 2; ++ai)
#pragma unroll
                for (int m = 0; m < 4; ++m) { const int row = row0 + ai * 128 + m * 16;
#pragma unroll
                    for (int bj = 0; bj < 2; ++bj) { const f32x4 v0 = acc[ai][bj][m][0], v1 = acc[ai][bj][m][1];
                        u32x4 w; w.x = pk2(v0[0], v0[1]); w.y = pk2(v0[2], v0[3]); w.z = pk2(v1[0], v1[1]); w.w = pk2(v1[2], v1[3]);
                        *(u32x4*)(proj + (frag ? pjf(row, col0 + bj * 128) : pj(row, col0 + bj * 128))) = w; } }
        } else if (wc == 0) {
            const f32x4 b0 = *(const f32x4*)(dt_bias + 8 * fq), b1 = *(const f32x4*)(dt_bias + 8 * fq + 4);
#pragma unroll
            for (int ai = 0; ai < 2; ++ai)
#pragma unroll
                for (int m = 0; m < 4; ++m) { float* dp = dt + (size_t)(row0 + ai * 128 + m * 16) * 32 + 8 * fq;
                    f32x4 v0 = acc[ai][0][m][0] + b0, v1 = acc[ai][0][m][1] + b1;
#pragma unroll
                    for (int e = 0; e < 4; ++e) { v0[e] = v0[e] > 20.f ? v0[e] : __logf(1.f + __expf(v0[e])); v1[e] = v1[e] > 20.f ? v1[e] : __logf(1.f + __expf(v1[e])); }
                    *(f32x4*)dp = v0; *(f32x4*)(dp + 4) = v1; }
        }
        return true;
    }
};


template <bool SAMP>
__device__ __forceinline__ void conv16(const u32x4 (&raw)[19], const f32x4 (&hs)[3][2], const float (&w)[4][8], const float (&bias)[8], int j0, bool zero_hist, int nv,
                                       LAS unsigned char* dst, int dstride, bool wr_state, float* cst) {
    float win[4][8];
#pragma unroll
    for (int r = 0; r < 19; ++r) {
        const int j = j0 + r - 3;
        const u32x4 q = raw[r];
        float* cur = win[r & 3];
        cur[0] = bflo(q.x); cur[1] = bfhi(q.x); cur[2] = bflo(q.y); cur[3] = bfhi(q.y); cur[4] = bflo(q.z); cur[5] = bfhi(q.z); cur[6] = bflo(q.w); cur[7] = bfhi(q.w);
        if (r < 3) {
            const bool hz = j < 0 && zero_hist;
            if (SAMP) { const bool hh = j < 0;
                cur[0] = hh ? hs[r < 3 ? r : 0][0].x : cur[0]; cur[1] = hh ? hs[r < 3 ? r : 0][0].y : cur[1]; cur[2] = hh ? hs[r < 3 ? r : 0][0].z : cur[2]; cur[3] = hh ? hs[r < 3 ? r : 0][0].w : cur[3];
                cur[4] = hh ? hs[r < 3 ? r : 0][1].x : cur[4]; cur[5] = hh ? hs[r < 3 ? r : 0][1].y : cur[5]; cur[6] = hh ? hs[r < 3 ? r : 0][1].z : cur[6]; cur[7] = hh ? hs[r < 3 ? r : 0][1].w : cur[7]; }
            else {
#pragma unroll
                for (int e = 0; e < 8; ++e) cur[e] = hz ? 0.f : cur[e]; }
        }
        if (SAMP) { const bool oob = j >= nv;
#pragma unroll
            for (int e = 0; e < 8; ++e) cur[e] = oob ? 0.f : cur[e]; }
        if (r >= 3) {
            const float* p3 = win[(r - 3) & 3]; const float* p2 = win[(r - 2) & 3]; const float* p1 = win[(r - 1) & 3];
            float o[8];
#pragma unroll
            for (int e = 0; e < 8; ++e) { const float t = __builtin_fmaf(w[3][e], cur[e], __builtin_fmaf(w[2][e], p1[e], __builtin_fmaf(w[1][e], p2[e], __builtin_fmaf(w[0][e], p3[e], bias[e]))));
                o[e] = silu_f(t); if (SAMP) o[e] = j < nv ? o[e] : 0.f; }
            u32x4 pk; pk.x = pk2(o[0], o[1]); pk.y = pk2(o[2], o[3]); pk.z = pk2(o[4], o[5]); pk.w = pk2(o[6], o[7]);
            *(LAS u32x4*)(dst + j * dstride) = pk;
            if (wr_state) { if (j >= nv - 3 && j < nv) { float* d = cst + (size_t)(j - (nv - 3)) * 3072;
                    *(f32x4*)d = (f32x4){cur[0], cur[1], cur[2], cur[3]}; *(f32x4*)(d + 4) = (f32x4){cur[4], cur[5], cur[6], cur[7]}; } }
        }
    }
}
constexpr int A_XC = 0, A_XCS = 1040, A_BM = 66560, A_CM = 83968, A_ST = 272, A_CBF = 101376, A_DTL = 118784, A_ACU = 120832;
__device__ __forceinline__ void ssd_item(const Params& P, LAS unsigned char* lds, unsigned ldsaddr, int ck, int g) {
    int tid_ = threadIdx.x; asm volatile("" : "+v"(tid_));
    const int tid = tid_, lane = tid & 63, wave = __builtin_amdgcn_readfirstlane(tid >> 6), fr = lane & 15, fq = lane >> 4;
    const bool samp = ck >= 128;
    int row0, nv, c, sidx;
    if (!samp) { sidx = ck >> 6; c = ck & 63; row0 = sidx * 4096 + c * 64; nv = 64; } else { sidx = ck - 128; c = 0; row0 = TP + sidx * 32; nv = 32; }
    const bf16_t* proj = (const bf16_t*)(P.ws + WS_PROJ);
    const float* DT = (const float*)(P.ws + WS_DT); float* EAC = (float*)(P.ws + WS_EAC); float* BDEC = (float*)(P.ws + WS_BDEC);
    bf16_t* YP = (bf16_t*)(P.ws + WS_YP); bf16_t* CPOST = (bf16_t*)(P.ws + WS_CPOST); bf16_t* S = (bf16_t*)(P.ws + WS_S);
    LAS float* DTL = (LAS float*)(lds + A_DTL); LAS float* ACU = (LAS float*)(lds + A_ACU);
    const bool act = tid < 384;
    {
        const int tcl = act ? tid : tid - 384;
        const int cg = tcl % 96, seg = tcl / 96, j0 = seg * 16;
        int ch0, dstoff, dstride;
        if (cg < 64) { ch0 = g * 512 + cg * 8; dstoff = A_XC + cg * 16; dstride = A_XCS; }
        else if (cg < 80) { ch0 = 2048 + g * 128 + (cg - 64) * 8; dstoff = A_BM + (cg - 64) * 16; dstride = A_ST; }
        else { ch0 = 2560 + g * 128 + (cg - 80) * 8; dstoff = A_CM + (cg - 80) * 16; dstride = A_ST; }
        float w[4][8], bias[8];
#pragma unroll
        for (int k = 0; k < 4; ++k) { const f32x4 a = *(const f32x4*)(P.in[10] + k * 3072 + ch0), b = *(const f32x4*)(P.in[10] + k * 3072 + ch0 + 4);
            w[k][0] = a.x; w[k][1] = a.y; w[k][2] = a.z; w[k][3] = a.w; w[k][4] = b.x; w[k][5] = b.y; w[k][6] = b.z; w[k][7] = b.w; }
        { const f32x4 a = *(const f32x4*)(P.in[11] + ch0), b = *(const f32x4*)(P.in[11] + ch0 + 4);
            bias[0] = a.x; bias[1] = a.y; bias[2] = a.z; bias[3] = a.w; bias[4] = b.x; bias[5] = b.y; bias[6] = b.z; bias[7] = b.w; }
        float p3[8], p2[8], p1[8];
#pragma unroll
        for (int e = 0; e < 8; ++e) { p3[e] = 0.f; p2[e] = 0.f; p1[e] = 0.f; }
        const bf16_t* src = proj + pj(row0, C_XS + ch0);
        const bool wr_state = samp || c == 63;
        float* cst = samp ? P.out + O_CONVS + (size_t)sidx * 3 * 3072 + ch0 : P.out + O_CONVP + (size_t)sidx * 3 * 3072 + ch0;
        u32x4 raw[19];
#pragma unroll
        for (int r = 0; r < 19; ++r) { const int j = j0 + r - 3; int jc = j < nv ? j : nv - 1; if ((samp || c == 0) && jc < 0) jc = 0; raw[r] = act ? __builtin_nontemporal_load((const u32x4*)(src + (long)jc * 256)) : (u32x4){0u, 0u, 0u, 0u}; }
        f32x4 hs[3][2];
#pragma unroll
        for (int r = 0; r < 3; ++r) { hs[r][0] = hs[r][1] = (f32x4){0.f, 0.f, 0.f, 0.f}; }
        if (samp) {
#pragma unroll
            for (int r = 0; r < 3; ++r) { const float* hp = P.in[3] + ((size_t)sidx * 3 + r) * 3072 + ch0; hs[r][0] = *(const f32x4*)hp; hs[r][1] = *(const f32x4*)(hp + 4); } }
        if (!act) {
            float dtv[4];
#pragma unroll
            for (int hq = 0; hq < 4; ++hq) { const int h = g * 8 + (wave - 6) * 4 + hq; dtv[hq] = lane < nv ? DT[(size_t)(row0 + lane) * 32 + h] : 0.f; }
#pragma unroll
            for (int hq = 0; hq < 4; ++hq) {
                const int hh = (wave - 6) * 4 + hq, h = g * 8 + hh, j = lane;
                const float dt = dtv[hq];
                const float a = -expf(P.in[13][h]);
                float x = dt * a;
#pragma unroll
                for (int o = 1; o < 64; o <<= 1) { const float y = __shfl_up(x, o); if (lane >= o) x += y; }
                DTL[hh * 64 + j] = dt; ACU[hh * 64 + j] = x;
                if (j < nv) EAC[(size_t)(row0 + j) * 32 + h] = __expf(x);
                const float last = __shfl(x, 63);
                if (lane == 0) BDEC[ck * 32 + h] = __expf(last);
            }
        }
        if (act) {
            if (samp) conv16<true>(raw, hs, w, bias, j0, false, nv, lds + dstoff, dstride, true, cst);
            else conv16<false>(raw, hs, w, bias, j0, c == 0, nv, lds + dstoff, dstride, wr_state, cst);
        }
    }
    __syncthreads();
    for (int q = tid; q < 1024; q += 512) { const int j = q & 63, n8 = q >> 6;
        if (j < nv) *(u32x4*)(CPOST + (size_t)(ck * 4 + g) * 8192 + (n8 * 64 + j) * 8) = *(const LAS u32x4*)(lds + A_CM + j * A_ST + n8 * 16); }
    for (int t2 = wave; t2 < 16; t2 += 8) {
        const int it = t2 >> 2, jt = t2 & 3;
        if (jt > it) continue;
        f32x4 acc = (f32x4){0.f, 0.f, 0.f, 0.f};
#pragma unroll
        for (int ks = 0; ks < 4; ++ks) { const bf16x8 a = rowfrag(lds + A_BM, jt * 16, A_ST, ks * 32, fr, fq), b = rowfrag(lds + A_CM, it * 16, A_ST, ks * 32, fr, fq); acc = mma16(a, b, acc); }
        *(LAS f32x4*)(lds + A_CBF + (it * 16 + fr) * 272 + (jt * 16 + fq * 4) * 4) = acc;
    }
    __syncthreads();
    {
        const int hh = wave, h = g * 8 + hh; const float dsk = P.in[14][h];
        bf16x8 xf[4][2];
        tr8_xc(ldsaddr + A_XC + hh * 128, lane, xf);
        float wj[2][8];
        const float alast = ACU[hh * 64 + 63];
#pragma unroll
        for (int ks = 0; ks < 2; ++ks) { const int jb = ks * 32 + fq * 8;
            const f32x4 aj0 = *(const LAS f32x4*)(ACU + hh * 64 + jb), aj1 = *(const LAS f32x4*)(ACU + hh * 64 + jb + 4);
            const f32x4 dt0 = *(const LAS f32x4*)(DTL + hh * 64 + jb), dt1 = *(const LAS f32x4*)(DTL + hh * 64 + jb + 4);
            wj[ks][0] = dt0.x * __expf(alast - aj0.x); wj[ks][1] = dt0.y * __expf(alast - aj0.y); wj[ks][2] = dt0.z * __expf(alast - aj0.z); wj[ks][3] = dt0.w * __expf(alast - aj0.w);
            wj[ks][4] = dt1.x * __expf(alast - aj1.x); wj[ks][5] = dt1.y * __expf(alast - aj1.y); wj[ks][6] = dt1.z * __expf(alast - aj1.z); wj[ks][7] = dt1.w * __expf(alast - aj1.w); }
#pragma unroll
        for (int it = 0; it < 4; ++it) {
            if (it * 16 >= nv) break;
            const int i = it * 16 + fr; const float ai = ACU[hh * 64 + i];
            f32x4 ya[4];
#pragma unroll
            for (int pt = 0; pt < 4; ++pt) ya[pt] = (f32x4){0.f, 0.f, 0.f, 0.f};
#pragma unroll
            for (int ks = 0; ks < 2; ++ks) {
                if (ks * 32 > it * 16 + 15) continue;
                const int jb = ks * 32 + fq * 8;
                const f32x4 aj0 = *(const LAS f32x4*)(ACU + hh * 64 + jb), aj1 = *(const LAS f32x4*)(ACU + hh * 64 + jb + 4);
                const f32x4 dt0 = *(const LAS f32x4*)(DTL + hh * 64 + jb), dt1 = *(const LAS f32x4*)(DTL + hh * 64 + jb + 4);
                const f32x4 cb0 = *(const LAS f32x4*)(lds + A_CBF + i * 272 + jb * 4), cb1 = *(const LAS f32x4*)(lds + A_CBF + i * 272 + jb * 4 + 16);
                const float aj[8] = {aj0.x, aj0.y, aj0.z, aj0.w, aj1.x, aj1.y, aj1.z, aj1.w};
                const float dj[8] = {dt0.x, dt0.y, dt0.z, dt0.w, dt1.x, dt1.y, dt1.z, dt1.w};
                const float cb[8] = {cb0.x, cb0.y, cb0.z, cb0.w, cb1.x, cb1.y, cb1.z, cb1.w};
                float m[8];
#pragma unroll
                for (int e = 0; e < 8; ++e) { const int j = jb + e; float v = (j <= i) ? cb[e] * __expf(ai - aj[e]) * dj[e] : 0.f; if (j == i) v += dsk; m[e] = v; }
                const bf16x8 mf = pack8(m);
#pragma unroll
                for (int pt = 0; pt < 4; ++pt) ya[pt] = mma16(xf[pt][ks], mf, ya[pt]);
            }
#pragma unroll
            for (int pp = 0; pp < 2; ++pp) { u32x4 o; o.x = pk2(ya[2 * pp][0], ya[2 * pp][1]); o.y = pk2(ya[2 * pp][2], ya[2 * pp][3]); o.z = pk2(ya[2 * pp + 1][0], ya[2 * pp + 1][1]); o.w = pk2(ya[2 * pp + 1][2], ya[2 * pp + 1][3]);
                *(u32x4*)(YP + (size_t)(ck * 32 + h) * 4096 + ((pp * 4 + fq) * 64 + i) * 8) = o; }
        }
#pragma unroll
        for (int pt = 0; pt < 4; ++pt)
#pragma unroll
            for (int ks = 0; ks < 2; ++ks) { const u32x4 xu = __builtin_bit_cast(u32x4, xf[pt][ks]);
                float xs[8] = {bflo(xu.x) * wj[ks][0], bfhi(xu.x) * wj[ks][1], bflo(xu.y) * wj[ks][2], bfhi(xu.y) * wj[ks][3], bflo(xu.z) * wj[ks][4], bfhi(xu.z) * wj[ks][5], bflo(xu.w) * wj[ks][6], bfhi(xu.w) * wj[ks][7]};
                xf[pt][ks] = pack8(xs); }
        bf16_t* sp = S + (size_t)(ck * 32 + h) * 8192;
#pragma unroll
        for (int nh = 0; nh < 2; ++nh) {
            bf16x8 bfr[4][2];
            tr8_bm(ldsaddr + A_BM + nh * 128, lane, bfr);
#pragma unroll
            for (int np = 0; np < 2; ++np)
#pragma unroll
                for (int pt = 0; pt < 4; ++pt) { u32x2 oo[2];
#pragma unroll
                    for (int k2 = 0; k2 < 2; ++k2) { const int nt = 2 * np + k2; f32x4 sa = mma16(bfr[nt][0], xf[pt][0], (f32x4){0.f, 0.f, 0.f, 0.f}); sa = mma16(bfr[nt][1], xf[pt][1], sa);
                        oo[k2].x = pk2(sa[0], sa[1]); oo[k2].y = pk2(sa[2], sa[3]); }
                    const u32x4 w = widen16(oo[0], oo[1]);
                    *(u32x4*)(sp + (((nh * 4 + 2 * np + (fq & 1)) * 2 + (fq >> 1)) * 64 + pt * 16 + fr) * 8) = w; }
        }
    }
    __syncthreads();
}
__device__ __forceinline__ void ln_item(const Params& P, int idx) {
    const int tid = threadIdx.x, lane = tid & 63, wave = tid >> 6;
    const bf16_t* proj = (const bf16_t*)(P.ws + WS_PROJ); float* LNS = (float*)(P.ws + WS_LNS);
    for (int q = 0; q < 5; ++q) {
        const int r = idx * 38 + wave + 8 * q;
        if (r >= T || r >= (idx + 1) * 38) break;
        u32x4 raw[4]; float s = 0.f;
#pragma unroll
        for (int j = 0; j < 4; ++j) { raw[j] = *(const u32x4*)(proj + pj(r, C_V + (lane + 64 * j) * 8)); s += (bflo(raw[j].x) + bfhi(raw[j].x)) + (bflo(raw[j].y) + bfhi(raw[j].y)) + (bflo(raw[j].z) + bfhi(raw[j].z)) + (bflo(raw[j].w) + bfhi(raw[j].w)); }
        const float mean = wave_sum(s) * (1.f / 2048.f); float s2 = 0.f;
#pragma unroll
        for (int j = 0; j < 4; ++j) { float d;
            d = bflo(raw[j].x) - mean; s2 += d * d; d = bfhi(raw[j].x) - mean; s2 += d * d; d = bflo(raw[j].y) - mean; s2 += d * d; d = bfhi(raw[j].y) - mean; s2 += d * d;
            d = bflo(raw[j].z) - mean; s2 += d * d; d = bfhi(raw[j].z) - mean; s2 += d * d; d = bflo(raw[j].w) - mean; s2 += d * d; d = bfhi(raw[j].w) - mean; s2 += d * d; }
        const float rstd = rsqrtf(wave_sum(s2) * (1.f / 2048.f) + EPS);
        if (lane == 0) { LNS[r * 2] = mean; LNS[r * 2 + 1] = rstd; }
    }
}
__device__ __forceinline__ void phase3(const Params& P, LAS unsigned char* lds, unsigned ldsaddr) {
#if DUPK == 31
    for (int it = blockIdx.x; it < 132; it += gridDim.x) ln_item(P, it);
#endif
#if DUPK == 32
    for (int it = blockIdx.x; it < 544; it += gridDim.x) ssd_item(P, lds, ldsaddr, it >> 2, it & 3);
#endif
    for (int it = blockIdx.x; it < 544 + 224; it += gridDim.x) {
        if (it < 544) ssd_item(P, lds, ldsaddr, it >> 2, it & 3); else ln_item(P, it - 544);
    }
}

template <bool DRY> __device__ __forceinline__ void scan_prompt_item(const Params& P, int item) {
    const int idx = item * 512 + threadIdx.x, n4 = idx & 31, p = (idx >> 5) & 63, h = (idx >> 11) & 31, s = idx >> 16;
    bf16_t* S = (bf16_t*)(P.ws + WS_S); bf16_t* SD = DRY ? (bf16_t*)(P.ws + WS_YZ) : S; const float* BDEC = (const float*)(P.ws + WS_BDEC);
    f32x4 hst = (f32x4){0.f, 0.f, 0.f, 0.f};
    bf16_t* sp0 = S + ((size_t)(s * 64 * 32 + h) * 64 + p) * 128 + n4 * 4;
    const float* bd0 = BDEC + (s * 64) * 32 + h;
    u32x2 raw[2][16]; float d[2][16];
#pragma unroll
    for (int q = 0; q < 16; ++q) { raw[0][q] = __builtin_nontemporal_load((const u32x2*)(sp0 + (size_t)q * 262144)); d[0][q] = bd0[q * 32]; }
#pragma unroll
    for (int b = 0; b < 4; ++b) {
        if (b < 3) {
#pragma unroll
            for (int q = 0; q < 16; ++q) { raw[(b + 1) & 1][q] = __builtin_nontemporal_load((const u32x2*)(sp0 + (size_t)((b + 1) * 16 + q) * 262144)); d[(b + 1) & 1][q] = bd0[((b + 1) * 16 + q) * 32]; } }
#pragma unroll
        for (int q = 0; q < 16; ++q) {
            u32x2 o; o.x = pk2(hst.x, hst.y); o.y = pk2(hst.z, hst.w);
            bf16_t* dst = DRY ? SD + (((size_t)((s * 64 + b * 16 + q) * 32 + h) * 64 + p) * 128 + n4 * 4) % (size_t)16777216 : sp0 + (size_t)(b * 16 + q) * 262144;
            *(u32x2*)dst = o;
            const u32x2 rr = raw[b & 1][q];
            const f32x4 sv = (f32x4){bflo(rr.x), bfhi(rr.x), bflo(rr.y), bfhi(rr.y)};
            hst = hst * d[b & 1][q] + sv; }
    }
    { const int f = p * 128 + n4 * 4, nb = f >> 9, pp = (f >> 3) & 63, e0 = f & 7;
      if (!DRY) *(f32x4*)(P.out + O_SSMP + ((size_t)(s * 32 + h) * 64 + pp) * 128 + nb * 8 + e0) = hst;
      else if (hst.x == 1.2345f) P.out[0] = 0.f; }
}
__device__ __forceinline__ void scan_sample_item(const Params& P, int item) {
    const bf16_t* S = (const bf16_t*)(P.ws + WS_S); const float* BDEC = (const float*)(P.ws + WS_BDEC);
#pragma unroll
    for (int q = 0; q < 4; ++q) {
        const int e = item * 512 + threadIdx.x + q * 131072, n4 = e & 31, p = (e >> 5) & 63, h = (e >> 11) & 31, sb = e >> 16;
        const int f = p * 128 + n4 * 4, nb = f >> 9, pp = (f >> 3) & 63, e0 = f & 7;
        const size_t off = ((size_t)(sb * 32 + h) * 64 + pp) * 128 + nb * 8 + e0;
        const f32x4 h0 = *(const f32x4*)(P.in[2] + off);
        const int ck = 128 + sb;
        const u32x2 raw = *(const u32x2*)(S + ((size_t)(ck * 32 + h) * 64 + p) * 128 + n4 * 4);
        const float d = BDEC[ck * 32 + h];
        const f32x4 sv = (f32x4){bflo(raw.x), bfhi(raw.x), bflo(raw.y), bfhi(raw.y)};
        *(f32x4*)(P.out + O_SSMS + off) = h0 * d + sv;
    }
}
__device__ __forceinline__ void wf_item(const Params& P, LAS unsigned char* lds, int m, int nb) {
    int tid = threadIdx.x; asm volatile("" : "+v"(tid));
    const u32x4* src = (const u32x4*)((const bf16_t*)(P.ws + WS_WB) + (size_t)m * 2048 * 2048 + (size_t)nb * 32 * KD);
    u32x4* dst = (u32x4*)((bf16_t*)(P.ws + WS_WF) + (size_t)m * 2048 * 2048);
    u32x4 v[16];
#pragma unroll
    for (int i = 0; i < 16; ++i) v[i] = src[tid + 512 * i];
#pragma unroll
    for (int i = 0; i < 16; ++i) { const int p = tid + 512 * i, n = p >> 8, kg = p & 255; *(LAS u32x4*)(lds + (kg * 33 + n) * 16) = v[i]; }
    __syncthreads();
#pragma unroll
    for (int i = 0; i < 16; ++i) { const int p = tid + 512 * i, kg = p >> 5, n = p & 31; dst[(size_t)kg * 2048 + nb * 32 + n] = *(const LAS u32x4*)(lds + (kg * 33 + n) * 16); }
    __syncthreads();
}
constexpr int B_VN = 0, B_VNS = 528, B_WS = 67584, B_WSS = 272;
__device__ __forceinline__ void gmlp_item(const Params& P, LAS unsigned char* lds, unsigned ldsaddr, int rowbase, int nv, int grp, int sb) {
    int tid_ = threadIdx.x; asm volatile("" : "+v"(tid_));
    const int tid = tid_, lane = tid & 63, wave = __builtin_amdgcn_readfirstlane(tid >> 6), fr = lane & 15, fq = lane >> 4;
    const bf16_t* proj = (const bf16_t*)(P.ws + WS_PROJ); const float* LNS = (const float*)(P.ws + WS_LNS); bf16_t* ymlp = (bf16_t*)(P.ws + WS_YMLP);
    {
        const float* wsp = P.in[18] + (size_t)grp * 128 * 128;
#pragma unroll
        for (int k = 0; k < 8; ++k) { const int q = tid + 512 * k, i = q >> 5, j4 = (q & 31) * 4;
            const f32x4 v = *(const f32x4*)(wsp + i * 128 + j4);
            u32x2 o; o.x = pk2(j4 <= i ? v.x : 0.f, j4 + 1 <= i ? v.y : 0.f); o.y = pk2(j4 + 2 <= i ? v.z : 0.f, j4 + 3 <= i ? v.w : 0.f);
            *(LAS u32x2*)(lds + B_WS + i * B_WSS + j4 * 2) = o; }
    }
    {
#pragma unroll
        for (int k = 0; k < 8; ++k) { const int q = tid + 512 * k, j = q >> 5, c8 = (q & 31) * 8;
            u32x4 o = (u32x4){0u, 0u, 0u, 0u};
            if (j < nv) {
                const int row = rowbase + j, ch = grp * 256 + c8;
                const u32x4 raw = __builtin_nontemporal_load((const u32x4*)(proj + pj(row, C_V + ch)));
                const float mean = LNS[row * 2], rstd = LNS[row * 2 + 1];
                const f32x4 g0 = *(const f32x4*)(P.in[16] + ch), g1 = *(const f32x4*)(P.in[16] + ch + 4), b0 = *(const f32x4*)(P.in[17] + ch), b1 = *(const f32x4*)(P.in[17] + ch + 4);
                f32x4 v0 = (f32x4){bflo(raw.x), bfhi(raw.x), bflo(raw.y), bfhi(raw.y)}, v1 = (f32x4){bflo(raw.z), bfhi(raw.z), bflo(raw.w), bfhi(raw.w)};
                v0 = (v0 - mean) * rstd * g0 + b0; v1 = (v1 - mean) * rstd * g1 + b1;
                o.x = pk2(v0.x, v0.y); o.y = pk2(v0.z, v0.w); o.z = pk2(v1.x, v1.y); o.w = pk2(v1.z, v1.w);
                if (sb >= 0) { float* vo = P.out + O_VS + ((size_t)sb * 32 + j) * 2048 + ch; *(f32x4*)vo = v0; *(f32x4*)(vo + 4) = v1; }
            }
            *(LAS u32x4*)(lds + B_VN + j * B_VNS + c8 * 2) = o; }
    }
    __syncthreads();
    const int pr = wave & 3, hf = wave >> 2, itA = pr, itB = 7 - pr;
    u32x4 upre[2][4], zpre[2][4];
#pragma unroll
    for (int t = 0; t < 2; ++t) { const int it = t ? itB : itA, i = it * 16 + fr, row = rowbase + (i < nv ? i : 0);
#pragma unroll
        for (int cp = 0; cp < 4; ++cp) { const int cc = grp * 256 + (hf * 8 + 2 * cp + (fq & 1)) * 16 + (fq >> 1) * 8;
            upre[t][cp] = __builtin_nontemporal_load((const u32x4*)(proj + pjf(row, C_U + cc))); zpre[t][cp] = __builtin_nontemporal_load((const u32x4*)(proj + pjf(row, C_ZM + cc))); } }
    f32x4 acc[2][8];
#pragma unroll
    for (int t = 0; t < 2; ++t)
#pragma unroll
        for (int ct = 0; ct < 8; ++ct) acc[t][ct] = (f32x4){0.f, 0.f, 0.f, 0.f};
#pragma unroll
    for (int ks = 0; ks < 4; ++ks) {
        if (ks * 32 >= nv) break;
        const bool vA = ks * 32 <= itA * 16 + 15, vB = ks * 32 <= itB * 16 + 15;
        if (!vA && !vB) continue;
        const bf16x8 wA = rowfrag(lds + B_WS, itA * 16, B_WSS, ks * 32, fr, fq), wB = rowfrag(lds + B_WS, itB * 16, B_WSS, ks * 32, fr, fq);
        bf16x8 xv[8];
        tr8_vn(ldsaddr + B_VN + ks * 32 * B_VNS + hf * 8 * 32, lane, xv);
#pragma unroll
        for (int ct = 0; ct < 8; ++ct) {
            if (vA) acc[0][ct] = mma16(xv[ct], wA, acc[0][ct]);
            if (vB) acc[1][ct] = mma16(xv[ct], wB, acc[1][ct]); }
    }
#pragma unroll
    for (int t = 0; t < 2; ++t) { const int it = t ? itB : itA, i = it * 16 + fr;
        if (i < nv) { const int row = rowbase + i; const float bs = P.in[19][grp * 128 + i]; u32x2 go[8], uq[8], zq[8];
#pragma unroll
            for (int cp = 0; cp < 4; ++cp) { unwiden16(upre[t][cp], uq[2 * cp], uq[2 * cp + 1]); unwiden16(zpre[t][cp], zq[2 * cp], zq[2 * cp + 1]); }
#pragma unroll
            for (int ct = 0; ct < 8; ++ct) {
                const u32x2 uu = uq[ct], zz = zq[ct];
                const f32x4 a = acc[t][ct];
                const float y0 = bflo(uu.x) * (a[0] + bs) * silu_f(bflo(zz.x)), y1 = bfhi(uu.x) * (a[1] + bs) * silu_f(bfhi(zz.x));
                const float y2 = bflo(uu.y) * (a[2] + bs) * silu_f(bflo(zz.y)), y3 = bfhi(uu.y) * (a[3] + bs) * silu_f(bfhi(zz.y));
                go[ct].x = pk2(y0, y1); go[ct].y = pk2(y2, y3); }
#pragma unroll
            for (int cp = 0; cp < 4; ++cp) { const u32x4 w = widen16(go[2 * cp], go[2 * cp + 1]); const int ccw = grp * 256 + (hf * 8 + 2 * cp + (fq & 1)) * 16 + (fq >> 1) * 8;
                *(u32x4*)(ymlp + (size_t)row * DM + ccw) = w;
                if (sb >= 0) *(u32x4*)((bf16_t*)(P.ws + WS_AS) + (size_t)256 * 256 * 8 + pjs(row - TP, ccw)) = w; } } }
    __syncthreads();
}
__device__ __forceinline__ void phase4(const Params& P, LAS unsigned char* lds, unsigned ldsaddr) {
#if DUPK == 41
    for (int it = blockIdx.x; it < 256; it += gridDim.x) scan_prompt_item<true>(P, it);
#endif
#if DUPK == 40
    for (int it = blockIdx.x; it < 576; it += gridDim.x) {
        if (it < 512) { const int grp = it & 7, cc = (it >> 3) & 31, s = it >> 8; gmlp_item(P, lds, ldsaddr, s * 4096 + cc * 128, 128, grp, -1); }
        else { const int q = it - 512, grp = q & 7, sb = q >> 3; gmlp_item(P, lds, ldsaddr, TP + sb * 32, 32, grp, sb); }
    }
#endif
    for (int it = blockIdx.x; it < 1088; it += gridDim.x) {
        if (it < 512) { const int grp = it & 7, cc = (it >> 3) & 31, s = it >> 8; gmlp_item(P, lds, ldsaddr, s * 4096 + cc * 128, 128, grp, -1); }
        else if (it < 576) { const int q = it - 512, grp = q & 7, sb = q >> 3; gmlp_item(P, lds, ldsaddr, TP + sb * 32, 32, grp, sb); }
        else if (it < 832) scan_prompt_item<false>(P, it - 576);
        else scan_sample_item(P, it - 832);
    }
}

__device__ __forceinline__ void yoff_item(const Params& P, LAS unsigned char* lds, int ck, int g) {
    const int tid = threadIdx.x, lane = tid & 63, wave = __builtin_amdgcn_readfirstlane(tid >> 6), fr = lane & 15, fq = lane >> 4;
    const bool samp = ck >= 128;
    int row0, nv, sb = 0;
    if (!samp) { row0 = (ck >> 6) * 4096 + (ck & 63) * 64; nv = 64; } else { sb = ck - 128; row0 = TP + sb * 32; nv = 32; }
    const int hh = wave, h = g * 8 + hh;
    const bf16_t* proj = (const bf16_t*)(P.ws + WS_PROJ); bf16_t* YZ = (bf16_t*)(P.ws + WS_YZ); const bf16_t* S = (const bf16_t*)(P.ws + WS_S); const bf16_t* CPOST = (const bf16_t*)(P.ws + WS_CPOST);
    const bf16_t* YP = (const bf16_t*)(P.ws + WS_YP); const float* EAC = (const float*)(P.ws + WS_EAC); float* SSQ = (float*)(P.ws + WS_SSQ);
    bf16x8 hp[4][4];
    if (!samp) {
        const bf16_t* sp = S + (size_t)(ck * 32 + h) * 8192;
#pragma unroll
        for (int pt = 0; pt < 4; ++pt)
#pragma unroll
            for (int ks = 0; ks < 4; ++ks) hp[pt][ks] = __builtin_nontemporal_load((const bf16x8*)(sp + ((ks * 4 + fq) * 64 + pt * 16 + fr) * 8));
    } else {
        const float* sp = P.in[2] + (size_t)(sb * 32 + h) * 8192;
#pragma unroll
        for (int pt = 0; pt < 4; ++pt)
#pragma unroll
            for (int ks = 0; ks < 4; ++ks) { const f32x4 a = *(const f32x4*)(sp + (pt * 16 + fr) * 128 + ks * 32 + fq * 8), b = *(const f32x4*)(sp + (pt * 16 + fr) * 128 + ks * 32 + fq * 8 + 4);
                u32x4 r; r.x = pk2(a.x, a.y); r.y = pk2(a.z, a.w); r.z = pk2(b.x, b.y); r.w = pk2(b.z, b.w); hp[pt][ks] = __builtin_bit_cast(bf16x8, r); }
    }
    LAS float* red = (LAS float*)lds;
    const int nit = nv >> 4;
    bf16x8 cf[4][4];
#pragma unroll
    for (int it = 0; it < 4; ++it) { const int il = (it < nit ? it * 16 + fr : fr);
#pragma unroll
        for (int ks = 0; ks < 4; ++ks) cf[it][ks] = *(const bf16x8*)(CPOST + (size_t)(ck * 4 + g) * 8192 + ((ks * 4 + fq) * 64 + il) * 8); }
    u32x4 ypre[2][2], zpre[2][2]; float eapre[2];
    { const int row = row0 + fr; eapre[0] = EAC[(size_t)row * 32 + h];
#pragma unroll
        for (int pt = 0; pt < 4; ++pt) { const int col = h * 64 + pt * 16 + fq * 4; if (!(pt & 1)) ypre[0][pt >> 1] = __builtin_nontemporal_load((const u32x4*)(YP + (size_t)(ck * 32 + h) * 4096 + (((pt >> 1) * 4 + fq) * 64 + fr) * 8)); if (!(pt & 1)) zpre[0][pt >> 1] = __builtin_nontemporal_load((const u32x4*)(proj + pjf(row, C_ZS + h * 64 + (pt + (fq & 1)) * 16 + (fq >> 1) * 8))); } }
#pragma unroll
    for (int it = 0; it < 4; ++it) {
        if (it >= nit) break;
        const int i = it * 16 + fr, row = row0 + i;
        if (it + 1 < 4 && it + 1 < nit) { const int rn = row + 16; eapre[(it + 1) & 1] = EAC[(size_t)rn * 32 + h];
#pragma unroll
            for (int pt = 0; pt < 4; ++pt) { const int col = h * 64 + pt * 16 + fq * 4; if (!(pt & 1)) ypre[(it + 1) & 1][pt >> 1] = __builtin_nontemporal_load((const u32x4*)(YP + (size_t)(ck * 32 + h) * 4096 + (((pt >> 1) * 4 + fq) * 64 + (it + 1) * 16 + fr) * 8)); if (!(pt & 1)) zpre[(it + 1) & 1][pt >> 1] = __builtin_nontemporal_load((const u32x4*)(proj + pjf(rn, C_ZS + h * 64 + (pt + (fq & 1)) * 16 + (fq >> 1) * 8))); } }
        f32x4 acc[4];
#pragma unroll
        for (int pt = 0; pt < 4; ++pt) acc[pt] = (f32x4){0.f, 0.f, 0.f, 0.f};
#pragma unroll
        for (int ks = 0; ks < 4; ++ks)
#pragma unroll
            for (int pt = 0; pt < 4; ++pt) acc[pt] = mma16(hp[pt][ks], cf[it][ks], acc[pt]);
        const float ea = eapre[it & 1]; float ssq = 0.f; u32x2 yo[4], zq[4];
        unwiden16(zpre[it & 1][0], zq[0], zq[1]); unwiden16(zpre[it & 1][1], zq[2], zq[3]);
#pragma unroll
        for (int pt = 0; pt < 4; ++pt) { const int col = h * 64 + pt * 16 + fq * 4;
            const u32x4 yq = ypre[it & 1][pt >> 1]; u32x2 yp; yp.x = (pt & 1) ? yq.z : yq.x; yp.y = (pt & 1) ? yq.w : yq.y; const u32x2 zz = zq[pt];
            const float y0 = (bflo(yp.x) + ea * acc[pt][0]) * silu_f(bflo(zz.x)), y1 = (bfhi(yp.x) + ea * acc[pt][1]) * silu_f(bfhi(zz.x));
            const float y2 = (bflo(yp.y) + ea * acc[pt][2]) * silu_f(bflo(zz.y)), y3 = (bfhi(yp.y) + ea * acc[pt][3]) * silu_f(bfhi(zz.y));
            ssq += (y0 * y0 + y1 * y1) + (y2 * y2 + y3 * y3);
            yo[pt].x = pk2(y0, y1); yo[pt].y = pk2(y2, y3); }
#pragma unroll
        for (int pp = 0; pp < 2; ++pp) { const u32x4 w = widen16(yo[2 * pp], yo[2 * pp + 1]); const int colw = h * 64 + (2 * pp + (fq & 1)) * 16 + (fq >> 1) * 8;
            *(u32x4*)(YZ + (size_t)row * DM + colw) = w;
            if (samp) *(u32x4*)((bf16_t*)(P.ws + WS_AS) + pjs(row - TP, colw)) = w; }
        ssq += __shfl_xor(ssq, 16); ssq += __shfl_xor(ssq, 32);
        if (fq == 0) red[hh * 64 + i] = ssq;
    }
    __syncthreads();
    if (tid < nv) { float v = 0.f;
#pragma unroll
        for (int q = 0; q < 8; ++q) v += red[q * 64 + tid];
        SSQ[(size_t)(row0 + tid) * 4 + g] = v; }
    __syncthreads();
}
__device__ __forceinline__ void phase5(const Params& P, LAS unsigned char* lds) {
    for (int it = blockIdx.x; it < 512; it += gridDim.x) yoff_item(P, lds, it >> 2, it & 3);
}
__device__ __forceinline__ void phase4b(const Params& P, LAS unsigned char* lds) {
    const int G = gridDim.x, first = G >= 64 ? G - 32 : 0, step = G >= 64 ? 32 : G;
    for (int e = (int)blockIdx.x - first; e < 32; e += step) if (e >= 0) yoff_item(P, lds, 128 + (e >> 2), e & 3);
}

struct SchedD {
    int G, c; const char* A0; const char* A1; const char* B0; const char* B1;
    __device__ __forceinline__ bool next(int i, Unit& u) const {
        const int L = (i >> 1) * G + c; if (L >= 256) return false;
        { const int xcd = L & 7, j = L >> 3; u.pm = xcd * 4 + (j & 3); u.pn = j >> 2; } u.w = i & 1; u.pad = 0;
        u.a = (u.w ? A1 : A0) + (size_t)u.pm * 256 * (DM * 2); u.b = (u.w ? B1 : B0) + (size_t)u.pn * 256 * (KD * 2); return true;
    }
};
struct EpiD {
    static constexpr bool PERM = true;
    const bf16_t* proj; bf16_t* mrg; const float* ssq;
    __device__ __forceinline__ bool operator()(f32x4 (&acc)[2][2][4][2], const Unit& u, int wr, int wc, int fr, int fq) const {
        const int row0 = u.pm * 256 + wr * 64 + fr, col0 = u.pn * 256 + wc * 32 + 8 * fq;
#pragma unroll
        for (int ai = 0; ai < 2; ++ai)
#pragma unroll
            for (int m = 0; m < 4; ++m) { const int row = row0 + ai * 128 + m * 16;
                float rs = 1.f;
                if (u.w == 0) { const f32x4 q = *(const f32x4*)(ssq + (size_t)row * 4); rs = rsqrtf(((q.x + q.y) + (q.z + q.w)) * (1.f / 2048.f) + EPS); }
#pragma unroll
                for (int bj = 0; bj < 2; ++bj) { const int col = col0 + bj * 128;
                    const u32x4 gm = __builtin_nontemporal_load((const u32x4*)(proj + pjf(row, C_GM + col)));
                    float eb[8] = {bflo(gm.x), bfhi(gm.x), bflo(gm.y), bfhi(gm.y), bflo(gm.z), bfhi(gm.z), bflo(gm.w), bfhi(gm.w)};
#pragma unroll
                    for (int e = 0; e < 8; ++e) eb[e] = 1.f + __expf(-fmaxf(eb[e], -30.f));
                    if (u.w == 0) {
                        const u32x4 gs = __builtin_nontemporal_load((const u32x4*)(proj + pjf(row, C_GS + col)));
                        float ea[8] = {bflo(gs.x), bfhi(gs.x), bflo(gs.y), bfhi(gs.y), bflo(gs.z), bfhi(gs.z), bflo(gs.w), bfhi(gs.w)};
#pragma unroll
                        for (int e = 0; e < 8; ++e) ea[e] = rs * eb[e] * __builtin_amdgcn_rcpf(1.f + __expf(-ea[e]));
                        acc[ai][bj][m][0] *= (f32x4){ea[0], ea[1], ea[2], ea[3]}; acc[ai][bj][m][1] *= (f32x4){ea[4], ea[5], ea[6], ea[7]};
                    } else {
#pragma unroll
                        for (int e = 0; e < 8; ++e) eb[e] = __builtin_amdgcn_rcpf(eb[e]);
                        const f32x4 v0 = acc[ai][bj][m][0] * (f32x4){eb[0], eb[1], eb[2], eb[3]}, v1 = acc[ai][bj][m][1] * (f32x4){eb[4], eb[5], eb[6], eb[7]};
                        u32x4 w; w.x = pk2(v0[0], v0[1]); w.y = pk2(v0[2], v0[3]); w.z = pk2(v1[0], v1[1]); w.w = pk2(v1[2], v1[3]);
                        *(u32x4*)(mrg + (size_t)row * DM + col) = w; } } }
        return u.w != 0;
    }
};
struct SchedE {
    int G, c; const char* A; const char* B;
    __device__ __forceinline__ bool next(int i, Unit& u) const {
        const int L = i * G + c; if (L >= 256) return false;
        { const int xcd = L & 7, j = L >> 3; u.pm = xcd * 4 + (j & 3); u.pn = j >> 2; } u.w = 0; u.pad = 0;
        u.a = A + (size_t)u.pm * 256 * (DM * 2); u.b = B + (size_t)u.pn * 256 * (KD * 2); return true;
    }
};
__device__ __forceinline__ void panel_wait(unsigned* cnt, unsigned need) {
    xb_add(cnt, 1u);
    unsigned sp = 0u;
    while (xb_ld(cnt) < need) { __builtin_amdgcn_s_sleep(1); if (++sp > (1u << 22)) break; }
}
struct EpiE {
    static constexpr bool PERM = false;
    const float* xp; const float* xs; const float* mods; const float* gfin; float* out; float* rss; unsigned* cnt; LAS unsigned char* lds;
    __device__ __forceinline__ bool operator()(f32x4 (&acc)[2][2][4][2], const Unit& u, int wr, int wc, int fr, int fq) const {
        const int tid = threadIdx.x;
        LAS float* part = (LAS float*)(lds + 131072);
        LAS float* rst = (LAS float*)(lds + 131072 + 4096);
        const int row0 = u.pm * 256 + wr * 64 + fr, col0 = u.pn * 256 + wc * 32 + 4 * fq;
        const float* gt = mods + stream_of(u.pm * 256) * 6144 + 4096;
        f32x4 gv[2][2];
#pragma unroll
        for (int bj = 0; bj < 2; ++bj)
#pragma unroll
            for (int n = 0; n < 2; ++n) gv[bj][n] = *(const f32x4*)(gt + col0 + bj * 128 + n * 16);
#pragma unroll
        for (int ai = 0; ai < 2; ++ai)
#pragma unroll
            for (int m = 0; m < 4; ++m) { const int row = row0 + ai * 128 + m * 16;
                const float* xr = row < TP ? xp + (size_t)row * DM : xs + (size_t)(row - TP) * DM;
                float ss = 0.f;
#pragma unroll
                for (int bj = 0; bj < 2; ++bj)
#pragma unroll
                    for (int n = 0; n < 2; ++n) { const int col = col0 + bj * 128 + n * 16;
                        const f32x4 o = __builtin_nontemporal_load((const f32x4*)(xr + col)) + gv[bj][n] * acc[ai][bj][m][n];
                        ss += (o.x * o.x + o.y * o.y) + (o.z * o.z + o.w * o.w);
                        acc[ai][bj][m][n] = o; }
                ss += __shfl_xor(ss, 16); ss += __shfl_xor(ss, 32);
                if (fq == 0) part[(ai * 128 + wr * 64 + m * 16 + fr) * 4 + wc] = ss; }
        __syncthreads();
        if (tid < 256) { const float v = (part[tid * 4] + part[tid * 4 + 1]) + (part[tid * 4 + 2] + part[tid * 4 + 3]);
            __hip_atomic_store(rss + (size_t)(u.pm * 256 + tid) * 32 + u.pn, v, __ATOMIC_RELAXED, __HIP_MEMORY_SCOPE_AGENT); }
        asm volatile("s_waitcnt vmcnt(0)" ::: "memory");
        __syncthreads();
        if (tid == 0) panel_wait(cnt + 64 * u.pm, 8u);
        __syncthreads();
        if (tid < 256) { float v = 0.f;
#pragma unroll
            for (int q = 0; q < 8; ++q) v += __hip_atomic_load(rss + (size_t)(u.pm * 256 + tid) * 32 + q, __ATOMIC_RELAXED, __HIP_MEMORY_SCOPE_AGENT);
            rst[tid] = rsqrtf(v * (1.f / DM) + EPS); }
        __syncthreads();
#pragma unroll
        for (int bj = 0; bj < 2; ++bj)
#pragma unroll
            for (int n = 0; n < 2; ++n) gv[bj][n] = *(const f32x4*)(gfin + col0 + bj * 128 + n * 16);
#pragma unroll
        for (int ai = 0; ai < 2; ++ai)
#pragma unroll
            for (int m = 0; m < 4; ++m) { const int rl = ai * 128 + wr * 64 + m * 16 + fr; const float r = rst[rl];
                float* op = out + (size_t)(u.pm * 256 + rl) * DM;
#pragma unroll
                for (int bj = 0; bj < 2; ++bj)
#pragma unroll
                    for (int n = 0; n < 2; ++n) { const int col = col0 + bj * 128 + n * 16; *(f32x4*)(op + col) = acc[ai][bj][m][n] * r * gv[bj][n]; } }
        return true;
    }
};
__device__ __forceinline__ f32x4 small_gemm(LAS unsigned char* lds, const bf16_t* As  , int rl0, const bf16_t* Wf  , int n0) {
    const int tid = threadIdx.x, lane = tid & 63, wave = __builtin_amdgcn_readfirstlane(tid >> 6), fr = lane & 15, fq = lane >> 4;
    f32x4 acc[2][4];
#pragma unroll
    for (int rt = 0; rt < 2; ++rt)
#pragma unroll
        for (int ct = 0; ct < 4; ++ct) acc[rt][ct] = (f32x4){0.f, 0.f, 0.f, 0.f};
    const bf16_t* ap = As + ((size_t)(wave * 32 + fq) * 256 + rl0 + fr) * 8; const bf16_t* bp = Wf + ((size_t)(wave * 32 + fq) * 2048 + n0 + fr) * 8;
    {
        bf16x8 af[2][8], bf[4][8];
#pragma unroll
        for (int ks = 0; ks < 8; ++ks) {
#pragma unroll
            for (int rt = 0; rt < 2; ++rt) af[rt][ks] = *(const bf16x8*)(ap + (size_t)ks * 4 * 256 * 8 + rt * 16 * 8);
#pragma unroll
            for (int ct = 0; ct < 4; ++ct) bf[ct][ks] = *(const bf16x8*)(bp + (size_t)ks * 4 * 2048 * 8 + ct * 16 * 8);
        }
        __builtin_amdgcn_sched_barrier(0);
#pragma unroll
        for (int ks = 0; ks < 8; ++ks)
#pragma unroll
            for (int rt = 0; rt < 2; ++rt)
#pragma unroll
                for (int ct = 0; ct < 4; ++ct) acc[rt][ct] = mma16(bf[ct][ks], af[rt][ks], acc[rt][ct]);
    }
#pragma unroll
    for (int rt = 0; rt < 2; ++rt)
#pragma unroll
        for (int ct = 0; ct < 4; ++ct) *(LAS f32x4*)(lds + ((wave * 8 + rt * 4 + ct) * 64 + lane) * 16) = acc[rt][ct];
    __syncthreads();
    f32x4 v = (f32x4){0.f, 0.f, 0.f, 0.f};
#pragma unroll
    for (int w = 0; w < 8; ++w) v += *(const LAS f32x4*)(lds + ((w * 8 + (tid >> 6)) * 64 + lane) * 16);
    __syncthreads();
    return v;
}
__device__ __forceinline__ void sample_merge(const Params& P, LAS unsigned char* lds) {
    const int tid = threadIdx.x, l = tid & 63, tile = tid >> 6, rt = tile >> 2, ct = tile & 3;
    const bf16_t* proj = (const bf16_t*)(P.ws + WS_PROJ);
    const bf16_t* AS = (const bf16_t*)(P.ws + WS_AS); const bf16_t* WF = (const bf16_t*)(P.ws + WS_WF); bf16_t* mrgs = (bf16_t*)(P.ws + WS_AS) + (size_t)2 * 256 * 256 * 8;
    const float* ssq = (const float*)(P.ws + WS_SSQ);
    for (int b = blockIdx.x; b < 256; b += gridDim.x) {
        const int r0 = TP + (b >> 5) * 32, n0 = (b & 31) * 64;
        const f32x4 v1 = small_gemm(lds, AS, r0 - TP, WF, n0);
        const f32x4 v2 = small_gemm(lds, AS + (size_t)256 * 256 * 8, r0 - TP, WF + (size_t)2048 * 2048, n0);
        const int row = r0 + rt * 16 + (l & 15), col = n0 + ct * 16 + (l >> 4) * 4;
        const f32x4 q = *(const f32x4*)(ssq + (size_t)row * 4); const float rs = rsqrtf(((q.x + q.y) + (q.z + q.w)) * (1.f / 2048.f) + EPS);
        const u32x2 gs = *(const u32x2*)(proj + pjf(row, C_GS + col)), gm = *(const u32x2*)(proj + pjf(row, C_GM + col));
        const float m0 = sigm_f(bflo(gs.x)) * rs * v1[0] + sigm_f(bflo(gm.x)) * v2[0], m1 = sigm_f(bfhi(gs.x)) * rs * v1[1] + sigm_f(bfhi(gm.x)) * v2[1];
        const float m2 = sigm_f(bflo(gs.y)) * rs * v1[2] + sigm_f(bflo(gm.y)) * v2[2], m3 = sigm_f(bfhi(gs.y)) * rs * v1[3] + sigm_f(bfhi(gm.y)) * v2[3];
        u32x2 o; o.x = pk2(m0, m1); o.y = pk2(m2, m3); *(u32x2*)(mrgs + pjs(row - TP, col)) = o;
    }
}
__device__ __forceinline__ void sample_out(const Params& P, LAS unsigned char* lds) {
    const int tid = threadIdx.x, l = tid & 63, tile = tid >> 6, rt = tile >> 2, ct = tile & 3;
    const bf16_t* Wof = (const bf16_t*)(P.ws + WS_WF) + (size_t)2 * 2048 * 2048; const bf16_t* mrgs = (const bf16_t*)(P.ws + WS_AS) + (size_t)2 * 256 * 256 * 8;
    const float* mods = (const float*)(P.ws + WS_MODS); float* rss = (float*)(P.ws + WS_RSS); unsigned* cnt = (unsigned*)(P.ws + WS_CNT);
    LAS float* rsum = (LAS float*)(lds + 65536);
    LAS float* rst = (LAS float*)(lds + 65536 + 512);
    for (int b = blockIdx.x; b < 256; b += gridDim.x) {
        const int sb = b >> 5, cb = b & 31, r0 = TP + sb * 32, n0 = cb * 64;
        const f32x4 v = small_gemm(lds, mrgs, r0 - TP, Wof, n0);
        const int m = rt * 16 + (l & 15), row = r0 + m, col = n0 + ct * 16 + (l >> 4) * 4;
        const f32x4 o = *(const f32x4*)(P.in[1] + (size_t)(row - TP) * DM + col) + *(const f32x4*)(mods + (2 + sb) * 6144 + 4096 + col) * v;
        float ss = (o.x * o.x + o.y * o.y) + (o.z * o.z + o.w * o.w);
        ss += __shfl_xor(ss, 16); ss += __shfl_xor(ss, 32);
        if ((l >> 4) == 0) rsum[m * 4 + ct] = ss;
        __syncthreads();
        if (tid < 32) __hip_atomic_store(rss + (size_t)(r0 + tid) * 32 + cb, (rsum[tid * 4] + rsum[tid * 4 + 1]) + (rsum[tid * 4 + 2] + rsum[tid * 4 + 3]), __ATOMIC_RELAXED, __HIP_MEMORY_SCOPE_AGENT);
        asm volatile("s_waitcnt vmcnt(0)" ::: "memory");
        __syncthreads();
        if (tid == 0) panel_wait(cnt + 64 * (32 + sb), 32u * (unsigned)((b - blockIdx.x) / gridDim.x + 1));
        __syncthreads();
        if (tid < 32) { float t = 0.f;
            for (int q = 0; q < 32; ++q) t += __hip_atomic_load(rss + (size_t)(r0 + tid) * 32 + q, __ATOMIC_RELAXED, __HIP_MEMORY_SCOPE_AGENT);
            rst[tid] = rsqrtf(t * (1.f / DM) + EPS); }
        __syncthreads();
        *(f32x4*)(P.out + (size_t)row * DM + col) = o * rst[m] * *(const f32x4*)(P.in[23] + col);
        __syncthreads();
    }
}
__device__ __forceinline__ void phase8(const Params& P) {
    const int tid = threadIdx.x, lane = tid & 63, wave = tid >> 6;
    const int gw = blockIdx.x * 8 + wave, NGW = gridDim.x * 8;
    const float* rss = (const float*)(P.ws + WS_RSS);
    for (int r = gw; r < T; r += NGW) {
        float s = lane < 32 ? rss[(size_t)r * 32 + lane] : 0.f;
        s = wave_sum(s);
        const float rstd = rsqrtf(s * (1.f / DM) + EPS);
        f32x4* op = (f32x4*)(P.out + (size_t)r * DM);
#pragma unroll
        for (int j = 0; j < 8; ++j) { const f32x4 g = *(const f32x4*)(P.in[23] + (lane + 64 * j) * 4); op[lane + 64 * j] = op[lane + 64 * j] * rstd * g; }
    }
}

__global__ __launch_bounds__(512, 2) void mega(Params P) {
    extern __shared__ __attribute__((aligned(16))) unsigned char smem[];
    LAS unsigned char* lds = (LAS unsigned char*)smem;
    const unsigned ldsaddr = (unsigned)(uintptr_t)smem;
    cg::grid_group grid = cg::this_grid();
    const int lo = P.ph_lo, hi = P.ph_hi;
    if (hi > 1000) grid.sync();
    volatile LAS unsigned* xst = (volatile LAS unsigned*)(lds + LDS_BYTES - 16);
    if (threadIdx.x == 0) { xst[0] = 0u; xst[1] = 0u; }
    __syncthreads();
    const XcdBarrier xb = xcd_barrier_post((unsigned*)(P.ws + WS_BAR), xst);
#define SEAM(k) if (lo < (k) && (k) < hi) xcd_barrier(xb)
#define REP(k) for (int rep_ = 0; rep_ < ((k) == DUPK ? 2 : 1); ++rep_, (((k) == DUPK && rep_ == 1) ? xcd_barrier(xb) : (void)0))
    if (lo <= 0 && 0 < hi) REP(0) phase0(P, lds);
    if (lo <= 1 && 1 < hi) REP(1) phase1(P);
    SEAM(2);
    if (lo <= 2 && 2 < hi) REP(2) {
        SchedIn S; S.nM = 33; S.nN = 61; S.nwg = 33 * 61; S.G = gridDim.x; S.c = blockIdx.x; S.A = (const char*)(P.ws + WS_H); S.B = (const char*)(P.ws + WS_WIN);
        EpiIn E; E.proj = (bf16_t*)(P.ws + WS_PROJ); E.dt = (float*)(P.ws + WS_DT); E.dt_bias = P.in[12];
        pg8::gemm_phase(lds, KD, KD * 2, S, E);
#if DUPK == 21
        xcd_barrier(xb);
        pg8::gemm_phase<false>(lds, KD, KD * 2, S, E);
#endif
    }
    SEAM(3);
    if (lo <= 3 && 3 < hi) REP(3) phase3(P, lds, ldsaddr);
    SEAM(4);
    if (lo <= 4 && 4 < hi) { phase4(P, lds, ldsaddr); phase4b(P, lds); }
    SEAM(5);
#if DUPK == 50
    xcd_barrier(xb); xcd_barrier(xb); xcd_barrier(xb); xcd_barrier(xb);
#endif
    if (lo <= 5 && 5 < hi) REP(5) phase5(P, lds);
    SEAM(6);
    if (lo <= 6 && 6 < hi) REP(6) {
        SchedD S; S.G = gridDim.x; S.c = blockIdx.x; S.A0 = (const char*)(P.ws + WS_YZ); S.A1 = (const char*)(P.ws + WS_YMLP);
        S.B0 = (const char*)(P.ws + WS_WB); S.B1 = (const char*)(P.ws + WS_WB) + (size_t)2048 * 2048 * 2;
        EpiD E; E.proj = (const bf16_t*)(P.ws + WS_PROJ); E.mrg = (bf16_t*)(P.ws + WS_MRG); E.ssq = (const float*)(P.ws + WS_SSQ);
        pg8::gemm_phase(lds, KD, DM * 2, S, E);
        sample_merge(P, lds);
#if DUPK == 60
        sample_merge(P, lds);
#endif
    }
    SEAM(7);
    if (lo <= 7 && 7 < hi) REP(7) {
        SchedE S; S.G = gridDim.x; S.c = blockIdx.x; S.A = (const char*)(P.ws + WS_MRG); S.B = (const char*)(P.ws + WS_WB) + (size_t)2 * 2048 * 2048 * 2;
        EpiE E; E.xp = P.in[0]; E.xs = P.in[1]; E.mods = (const float*)(P.ws + WS_MODS); E.gfin = P.in[23]; E.out = P.out; E.rss = (float*)(P.ws + WS_RSS); E.cnt = (unsigned*)(P.ws + WS_CNT); E.lds = lds;
        pg8::gemm_phase(lds, KD, DM * 2, S, E);
        sample_out(P, lds);
    }
#undef SEAM
}

#ifndef N_LAUNCH_PER_PHASE
#define N_LAUNCH_PER_PHASE 0
#endif
extern "C" void kernel_launch(void* const* d_in, const int* in_sizes, int n_in, void* d_out, int out_size, void* d_ws, size_t ws_size, hipStream_t stream) {
    static int grid = 0;
    if (grid == 0) {
        if (n_in != 24 || ws_size < WS_END) { fprintf(stderr, "kernel_launch: unexpected n_in %d / ws_size %zu\n", n_in, ws_size); grid = -1; return; }
        int dev = 0, cus = 0, per_cu = 0;
        hipGetDevice(&dev); hipDeviceGetAttribute(&cus, hipDeviceAttributeMultiprocessorCount, dev);
        if (hipFuncSetAttribute((const void*)mega, hipFuncAttributeMaxDynamicSharedMemorySize, LDS_BYTES) != hipSuccess) { fprintf(stderr, "kernel_launch: hipFuncSetAttribute failed\n"); grid = -1; return; }
        if (hipOccupancyMaxActiveBlocksPerMultiprocessor(&per_cu, (const void*)mega, 512, LDS_BYTES) != hipSuccess || per_cu < 1) { fprintf(stderr, "kernel_launch: occupancy query gave %d\n", per_cu); per_cu = 1; }
        (void)hipGetLastError();
        grid = cus;
        fprintf(stderr, "kernel_launch: cus %d per_cu %d grid %d\n", cus, per_cu, grid);
    }
    if (grid < 0) return;
    if (hipMemsetAsync((char*)d_ws + WS_BAR, 0, 32768, stream) != hipSuccess) { fprintf(stderr, "kernel_launch: memset failed\n"); return; }
    Params p{};
    for (int i = 0; i < 24; ++i) p.in[i] = (const float*)d_in[i];
    p.out = (float*)d_out; p.ws = (unsigned char*)d_ws;
#if N_LAUNCH_PER_PHASE
    for (int ph = 0; ph < 8; ++ph) { p.ph_lo = ph; p.ph_hi = ph + 1; hipLaunchKernelGGL(mega, dim3(grid), dim3(512), LDS_BYTES, stream, p); }
#else
    p.ph_lo = 0; p.ph_hi = 8;
    void* args[] = {&p};
    hipError_t e = hipLaunchCooperativeKernel((const void*)mega, dim3(grid), dim3(512), args, LDS_BYTES, stream);
    if (e != hipSuccess) fprintf(stderr, "cooperative launch failed: %s (grid %d)\n", hipGetErrorString(e), grid);
#endif
}
```
